# Optimizing an MI355X kernel written in HIP

```python
import math
import jax, jax.numpy as jnp
from jax import lax
import numpy as np

D_MODEL = 1024
BATCH = 2
SEQ = 8192
DEPTH = 4
DEC_BATCH = 128
DEC_SEQ = 4
PAST_LEN = 2048
PAGE_SIZE = 128

N_A_LAYERS = (DEPTH + 1) // 2
N_C_LAYERS = DEPTH // 2
NSA_HEADS = 8
NSA_KV_HEADS = 2
HEAD_DIM = 64
HPG = NSA_HEADS // NSA_KV_HEADS
NSA_WIDTH = NSA_HEADS * HEAD_DIM
KV_WIDTH = NSA_KV_HEADS * HEAD_DIM
CMP_BLOCK = 64
N_SEL = 16
WINDOW = 512
Q_BLOCK = 128
GMLP_GROUPS = 4
GMLP_CHUNK = 128
GMLP_WIDTH = D_MODEL // 2
GMLP_GROUP_DIM = GMLP_WIDTH // GMLP_GROUPS
LRU_WIDTH = D_MODEL
LRU_HEADS = 8
LRU_BLOCK = LRU_WIDTH // LRU_HEADS
CONV_WIDTH = 4
LRU_C = 8.0
REL_BUCKETS = 32
REL_MAX_DIST = 1024
EPS = 1e-6
NEG = -1e30
SPLIT_A = (NSA_WIDTH, 6 * KV_WIDTH, 3 * NSA_HEADS, NSA_WIDTH, GMLP_WIDTH, GMLP_WIDTH, GMLP_WIDTH)
PROJ_A = sum(SPLIT_A)
OUT_A = NSA_WIDTH + GMLP_WIDTH

kernel_name = 'hybrid_nsa_gmlp_rglru_step'


def rms_norm(x, g):
    xf = x.astype(jnp.float32)
    y = xf * lax.rsqrt(jnp.mean(xf * xf, axis=-1, keepdims=True) + EPS)
    return (y * g.astype(jnp.float32)).astype(x.dtype)


def rel_bucket(d):
    max_exact = REL_BUCKETS // 2
    df = jnp.maximum(d, 1).astype(jnp.float32)
    large = max_exact + (jnp.log(df / max_exact) / math.log(REL_MAX_DIST / max_exact)
                         * (REL_BUCKETS - max_exact)).astype(jnp.int32)
    return jnp.where(d < max_exact, d, jnp.minimum(large, REL_BUCKETS - 1))


def nsa_block(qb, qpos, kc, vc, kc_end, ks_t, vs_t, kw, vw, wpos, rel_bias):
    B, Tb = qb.shape[0], qb.shape[1]
    f32 = jnp.float32
    scale = HEAD_DIM ** -0.5
    qg = qb.reshape(B, Tb, NSA_KV_HEADS, HPG, HEAD_DIM)
    tab = rel_bias.astype(f32).reshape(REL_BUCKETS, NSA_KV_HEADS, HPG)
    s_c = jnp.einsum('btghd,bngd->bghtn', qg, kc).astype(f32) * scale
    d_c = qpos[:, None] - kc_end[None, :]
    ok_c = d_c >= 0
    s_c = s_c + jnp.transpose(tab[rel_bucket(jnp.maximum(d_c, 0))], (2, 3, 0, 1))
    p_c = jax.nn.softmax(jnp.where(ok_c, s_c, NEG), axis=-1) * ok_c
    o_c = jnp.einsum('bghtn,bngd->btghd', p_c.astype(vc.dtype), vc)
    n_blk = kc.shape[1]
    blk = jnp.arange(n_blk, dtype=jnp.int32)[None, :]
    cur = (qpos // CMP_BLOCK)[:, None]
    forced = (blk == 0) | (blk == cur) | (blk == cur - 1)
    score = jnp.where(forced, jnp.inf, jnp.where(blk < cur, p_c.sum(axis=2), -jnp.inf))
    top_s, top_i = lax.top_k(score, min(N_SEL, n_blk))
    bi = jnp.arange(B)[:, None, None, None]
    gi = jnp.arange(NSA_KV_HEADS)[None, :, None, None]
    k_s = ks_t[bi, gi, top_i]
    v_s = vs_t[bi, gi, top_i]
    kpos = top_i[..., None] * CMP_BLOCK + jnp.arange(CMP_BLOCK, dtype=jnp.int32)
    d_s = qpos[None, None, :, None, None] - kpos
    ok_s = (top_s > -jnp.inf)[..., None] & (d_s >= 0)
    tab_g = jnp.transpose(tab, (1, 0, 2))
    b_s = jnp.moveaxis(tab_g[gi[..., None], rel_bucket(jnp.maximum(d_s, 0))], -1, 2)
    s_s = jnp.einsum('btghd,bgtkcd->bghtkc', qg, k_s).astype(f32) * scale + b_s
    s_s = jnp.where(ok_s[:, :, None], s_s, NEG)
    n_key = s_s.shape[-2] * CMP_BLOCK
    p_s = jax.nn.softmax(s_s.reshape(B, NSA_KV_HEADS, HPG, Tb, n_key), axis=-1)
    o_s = jnp.einsum('bghtk,bgtkd->btghd', p_s.astype(v_s.dtype),
                     v_s.reshape(B, NSA_KV_HEADS, Tb, n_key, HEAD_DIM))
    s_w = jnp.einsum('btghd,bkgd->bghtk', qg, kw).astype(f32) * scale
    d_w = qpos[:, None] - wpos[None, :]
    ok_w = (d_w >= 0) & (d_w <= WINDOW) & (wpos >= 0)[None, :]
    s_w = s_w + jnp.transpose(tab[rel_bucket(jnp.maximum(d_w, 0))], (2, 3, 0, 1))
    p_w = jax.nn.softmax(jnp.where(ok_w, s_w, NEG), axis=-1)
    o_w = jnp.einsum('bghtk,bkgd->btghd', p_w.astype(vw.dtype), vw)
    shp = (B, Tb, NSA_HEADS, HEAD_DIM)
    return (o_c.reshape(shp), o_s.reshape(shp), o_w.reshape(shp))


def mixer_ab(h, pos0, past_kv, win_kv, w_in, b_gate, pe_cmp, w_cmp, ln_g, ln_b, w_sp, b_sp, w_out, rel_bias):
    B, T, _ = h.shape
    f32 = jnp.float32
    idx = [int(i) for i in np.cumsum(SPLIT_A)[:-1]]
    proj = jnp.einsum('btd,de->bte', h, w_in)
    q, kv6, g_logit, z_nsa, u, v, z_g = jnp.split(proj, idx, axis=-1)
    q = q.reshape(B, T, NSA_HEADS, HEAD_DIM)
    kv6 = kv6.reshape(B, T, 6, NSA_KV_HEADS, HEAD_DIM)
    new_rows = kv6[:, :, :4]
    win_rows = kv6[:, :, 4:]
    full = new_rows if past_kv is None else jnp.concatenate([past_kv.astype(new_rows.dtype), new_rows], axis=1)
    L = full.shape[1]
    n_blk = -(-L // CMP_BLOCK)
    fb = jnp.pad(full, ((0, 0), (0, n_blk * CMP_BLOCK - L), (0, 0), (0, 0), (0, 0)))
    fb = fb.reshape(B, n_blk, CMP_BLOCK, 4, NSA_KV_HEADS, HEAD_DIM)
    kc = jnp.einsum('bngd,de->bnge', jnp.mean(fb[:, :, :, 0] + pe_cmp[0][None, None, :, None, :], axis=2), w_cmp[0])
    vc = jnp.einsum('bngd,de->bnge', jnp.mean(fb[:, :, :, 1] + pe_cmp[1][None, None, :, None, :], axis=2), w_cmp[1])
    kc_end = jnp.arange(n_blk, dtype=jnp.int32) * CMP_BLOCK + (CMP_BLOCK - 1)
    ks_t = jnp.transpose(fb[:, :, :, 2], (0, 3, 1, 2, 4))
    vs_t = jnp.transpose(fb[:, :, :, 3], (0, 3, 1, 2, 4))
    if win_kv is None:
        nb = T // Q_BLOCK
        wpad = jnp.pad(win_rows, ((0, 0), (WINDOW, 0), (0, 0), (0, 0), (0, 0)))

        def body(i):
            start = i * Q_BLOCK
            qb = lax.dynamic_slice_in_dim(q, start, Q_BLOCK, axis=1)
            wb = lax.dynamic_slice_in_dim(wpad, start, WINDOW + Q_BLOCK, axis=1)
            qpos = pos0 + start + jnp.arange(Q_BLOCK, dtype=jnp.int32)
            wpos = pos0 + start - WINDOW + jnp.arange(WINDOW + Q_BLOCK, dtype=jnp.int32)
            return nsa_block(qb, qpos, kc, vc, kc_end, ks_t, vs_t, wb[:, :, 0], wb[:, :, 1], wpos, rel_bias)

        oc, osl, ow = lax.map(body, jnp.arange(nb, dtype=jnp.int32))
        oc = jnp.swapaxes(oc, 0, 1).reshape(B, T, NSA_HEADS, HEAD_DIM)
        osl = jnp.swapaxes(osl, 0, 1).reshape(B, T, NSA_HEADS, HEAD_DIM)
        ow = jnp.swapaxes(ow, 0, 1).reshape(B, T, NSA_HEADS, HEAD_DIM)
        win_state = win_rows[:, T - min(WINDOW, T):]
    else:
        wb_len = win_kv.shape[1]
        wk = jnp.concatenate([win_kv.astype(win_rows.dtype), win_rows], axis=1)
        wpos = pos0 - wb_len + jnp.arange(wb_len + T, dtype=jnp.int32)
        qpos = pos0 + jnp.arange(T, dtype=jnp.int32)
        oc, osl, ow = nsa_block(q, qpos, kc, vc, kc_end, ks_t, vs_t, wk[:, :, 0], wk[:, :, 1], wpos, rel_bias)
        win_state = win_rows
    g = jax.nn.sigmoid((g_logit + b_gate).astype(f32)).reshape(B, T, 3, NSA_HEADS, 1)
    o = (g[:, :, 0] * oc + g[:, :, 1] * osl + g[:, :, 2] * ow).astype(h.dtype).reshape(B, T, NSA_WIDTH)
    y_nsa = o * jax.nn.silu(z_nsa)
    vf = v.astype(f32)
    mu = jnp.mean(vf, axis=-1, keepdims=True)
    var = jnp.mean(jnp.square(vf - mu), axis=-1, keepdims=True)
    vn = ((vf - mu) * lax.rsqrt(var + EPS) * ln_g.astype(f32) + ln_b.astype(f32)).astype(v.dtype)
    tc = min(T, GMLP_CHUNK)
    nc = T // tc
    wm = jnp.tril(w_sp[:, :tc, :tc])
    vb = vn.reshape(B, nc, tc, GMLP_GROUPS, GMLP_GROUP_DIM)
    mix = jnp.einsum('gij,bnjgd->bnigd', wm, vb) + jnp.transpose(b_sp[:, :tc])[None, None, :, :, None]
    y_g = (u.reshape(B, nc, tc, GMLP_GROUPS, GMLP_GROUP_DIM) * mix).reshape(B, T, GMLP_WIDTH) * jax.nn.silu(z_g)
    out = jnp.einsum('bte,ed->btd', jnp.concatenate([y_nsa, y_g], axis=-1), w_out)
    return out, new_rows, win_state, vn


def mixer_c(h, h0, conv0, w_in, conv_w, conv_b, w_ra, b_ra, w_rx, b_rx, lam, w_out):
    B, T, _ = h.shape
    f32 = jnp.float32
    xb, z = jnp.split(jnp.einsum('btd,de->bte', h, w_in), 2, axis=-1)
    xin = jnp.concatenate([conv0.astype(xb.dtype), xb], axis=1)
    xc = conv_b + xin[:, 0:T] * conv_w[0]
    for k in range(1, CONV_WIDTH):
        xc = xc + xin[:, k:k + T] * conv_w[k]
    xr = xc.reshape(B, T, LRU_HEADS, LRU_BLOCK)
    r = jax.nn.sigmoid((jnp.einsum('bthi,hij->bthj', xr, w_ra).reshape(B, T, LRU_WIDTH) + b_ra).astype(f32))
    ig = jax.nn.sigmoid((jnp.einsum('bthi,hij->bthj', xr, w_rx).reshape(B, T, LRU_WIDTH) + b_rx).astype(f32))
    log_a = -LRU_C * r * jax.nn.softplus(-lam.astype(f32))
    a = jnp.exp(log_a)
    bt = jnp.sqrt(-jnp.expm1(2.0 * log_a)) * ig * xc.astype(f32)

    def step(hc, ab):
        hn = ab[0] * hc + ab[1]
        return hn, hn

    h_last, hs = lax.scan(step, h0.astype(f32), (jnp.swapaxes(a, 0, 1), jnp.swapaxes(bt, 0, 1)))
    y = jnp.swapaxes(hs, 0, 1).astype(h.dtype) * jax.nn.silu(z)
    return jnp.einsum('btw,wd->btd', y, w_out), h_last, xin[:, -(CONV_WIDTH - 1):]


def setup_inputs(seed: int = 0) -> dict:
    key = jax.random.key(seed)
    ks = jax.random.split(key, 32)
    n_pages = PAST_LEN // PAGE_SIZE
    n_pool = (5 * DEC_BATCH * n_pages + 3) // 4

    def nrm(k, shape, scale):
        return jax.random.normal(k, shape, jnp.float32) * scale

    u = jax.random.uniform(ks[25], (N_C_LAYERS, LRU_WIDTH), jnp.float32, minval=0.9, maxval=0.999)
    return {
        'x_prompt': nrm(ks[0], (BATCH, SEQ, D_MODEL), 1.0),
        'x_sample': nrm(ks[1], (DEC_BATCH, DEC_SEQ, D_MODEL), 1.0),
        'cache_nsa': nrm(ks[2], (N_A_LAYERS, n_pool, PAGE_SIZE, 4, NSA_KV_HEADS, HEAD_DIM), 1.0),
        'cache_win': nrm(ks[3], (N_A_LAYERS, DEC_BATCH, min(WINDOW, PAST_LEN), 2, NSA_KV_HEADS, HEAD_DIM), 1.0),
        'state_lru_h': nrm(ks[4], (N_C_LAYERS, DEC_BATCH, LRU_WIDTH), 0.5),
        'state_lru_conv': nrm(ks[5], (N_C_LAYERS, DEC_BATCH, CONV_WIDTH - 1, LRU_WIDTH), 1.0),
        'page_table': jax.random.permutation(ks[6], n_pool)[:DEC_BATCH * n_pages].reshape(DEC_BATCH, n_pages).astype(jnp.int32),
        'norm_a': 1.0 + nrm(ks[7], (N_A_LAYERS, D_MODEL), 0.05),
        'w_in_a': nrm(ks[8], (N_A_LAYERS, D_MODEL, PROJ_A), D_MODEL ** -0.5),
        'b_gate_a': nrm(ks[9], (N_A_LAYERS, 3 * NSA_HEADS), 0.1),
        'pe_cmp': nrm(ks[10], (N_A_LAYERS, 2, CMP_BLOCK, HEAD_DIM), 0.1),
        'w_cmp': nrm(ks[11], (N_A_LAYERS, 2, HEAD_DIM, HEAD_DIM), math.sqrt(CMP_BLOCK / HEAD_DIM)),
        'gmlp_ln_g': 1.0 + nrm(ks[12], (N_A_LAYERS, GMLP_WIDTH), 0.05),
        'gmlp_ln_b': nrm(ks[13], (N_A_LAYERS, GMLP_WIDTH), 0.02),
        'w_spatial': nrm(ks[14], (N_A_LAYERS, GMLP_GROUPS, GMLP_CHUNK, GMLP_CHUNK), GMLP_CHUNK ** -0.5),
        'b_spatial': 1.0 + nrm(ks[15], (N_A_LAYERS, GMLP_GROUPS, GMLP_CHUNK), 0.1),
        'w_out_a': nrm(ks[16], (N_A_LAYERS, OUT_A, D_MODEL), OUT_A ** -0.5),
        'norm_c': 1.0 + nrm(ks[17], (N_C_LAYERS, D_MODEL), 0.05),
        'w_in_c': nrm(ks[18], (N_C_LAYERS, D_MODEL, 2 * LRU_WIDTH), D_MODEL ** -0.5),
        'conv_w': nrm(ks[19], (N_C_LAYERS, CONV_WIDTH, LRU_WIDTH), CONV_WIDTH ** -0.5),
        'conv_b': nrm(ks[20], (N_C_LAYERS, LRU_WIDTH), 0.02),
        'w_rg_a': nrm(ks[21], (N_C_LAYERS, LRU_HEADS, LRU_BLOCK, LRU_BLOCK), LRU_BLOCK ** -0.5),
        'b_rg_a': nrm(ks[22], (N_C_LAYERS, LRU_WIDTH), 0.1),
        'w_rg_x': nrm(ks[23], (N_C_LAYERS, LRU_HEADS, LRU_BLOCK, LRU_BLOCK), LRU_BLOCK ** -0.5),
        'b_rg_x': nrm(ks[24], (N_C_LAYERS, LRU_WIDTH), 0.1),
        'lru_lambda': jnp.log(u) - jnp.log1p(-u),
        'w_out_c': nrm(ks[26], (N_C_LAYERS, LRU_WIDTH, D_MODEL), LRU_WIDTH ** -0.5),
        'rel_bias': nrm(ks[27], (REL_BUCKETS, NSA_HEADS), 0.2),
        'final_norm': 1.0 + nrm(ks[28], (D_MODEL,), 0.05),
    }


def reference(x_prompt, x_sample, cache_nsa, cache_win, state_lru_h, state_lru_conv, page_table,
              norm_a, w_in_a, b_gate_a, pe_cmp, w_cmp, gmlp_ln_g, gmlp_ln_b, w_spatial, b_spatial, w_out_a,
              norm_c, w_in_c, conv_w, conv_b, w_rg_a, b_rg_a, w_rg_x, b_rg_x, lru_lambda, w_out_c,
              rel_bias, final_norm):
    dec_b, n_pages = page_table.shape
    past_len = n_pages * PAGE_SIZE
    bp = x_prompt.shape[0]
    yp, ys = x_prompt, x_sample
    nsa_p, nsa_s, win_p, win_s, gv_s = [], [], [], [], []
    h_p, h_s, cv_p, cv_s = [], [], [], []
    for layer in range(DEPTH):
        if layer % 2 == 0:
            a = layer // 2
            op, rows_p, wp, _ = mixer_ab(rms_norm(yp, norm_a[a]), 0, None, None,
                                         w_in_a[a], b_gate_a[a], pe_cmp[a], w_cmp[a], gmlp_ln_g[a], gmlp_ln_b[a],
                                         w_spatial[a], b_spatial[a], w_out_a[a], rel_bias)
            past = cache_nsa[a][page_table].reshape(dec_b, past_len, 4, NSA_KV_HEADS, HEAD_DIM)
            os_, rows_s, ws, vn_s = mixer_ab(rms_norm(ys, norm_a[a]), past_len, past, cache_win[a],
                                             w_in_a[a], b_gate_a[a], pe_cmp[a], w_cmp[a], gmlp_ln_g[a], gmlp_ln_b[a],
                                             w_spatial[a], b_spatial[a], w_out_a[a], rel_bias)
            nsa_p.append(rows_p); nsa_s.append(rows_s); win_p.append(wp); win_s.append(ws); gv_s.append(vn_s)
        else:
            c = layer // 2
            op, hp_, cp_ = mixer_c(rms_norm(yp, norm_c[c]), jnp.zeros((bp, LRU_WIDTH), jnp.float32),
                                   jnp.zeros((bp, CONV_WIDTH - 1, LRU_WIDTH), yp.dtype),
                                   w_in_c[c], conv_w[c], conv_b[c], w_rg_a[c], b_rg_a[c], w_rg_x[c], b_rg_x[c],
                                   lru_lambda[c], w_out_c[c])
            os_, hs_, cs_ = mixer_c(rms_norm(ys, norm_c[c]), state_lru_h[c], state_lru_conv[c],
                                    w_in_c[c], conv_w[c], conv_b[c], w_rg_a[c], b_rg_a[c], w_rg_x[c], b_rg_x[c],
                                    lru_lambda[c], w_out_c[c])
            h_p.append(hp_); h_s.append(hs_); cv_p.append(cp_); cv_s.append(cs_)
        yp = yp + op
        ys = ys + os_
    y_prompt = rms_norm(yp, final_norm)
    y_sample = rms_norm(ys, final_norm)
    return (y_prompt, y_sample, jnp.stack(nsa_p), jnp.stack(nsa_s), jnp.stack(win_p), jnp.stack(win_s),
            jnp.stack(gv_s), jnp.stack(h_p), jnp.stack(h_s), jnp.stack(cv_p), jnp.stack(cv_s))
```

```cpp
#include <hip/hip_runtime.h>
#include <cstdio>
#include <cstdint>
namespace pg8 {
#define PG8_LAS __attribute__((address_space(3)))
typedef unsigned short bf16_t;
typedef short bf16x8 __attribute__((ext_vector_type(8)));
typedef float f32x4 __attribute__((ext_vector_type(4)));
typedef unsigned u32x4 __attribute__((ext_vector_type(4)));
constexpr int BM = 256, BK = 64, HALF = 128, HTB = HALF * BK * 2  , STAGE_BYTES = 8 * HTB, NXCD = 8, WGM = 8;

__host__ __device__ __forceinline__ int lds_byte(int r, int c) { const int st = (r >> 4) * 2 + (c >> 5), rr = r & 15, cc = c & 31, ob = rr * 64 + cc * 2; return st * 1024 + (ob ^ (((ob >> 9) & 1) << 5)); }
__host__ __device__ __forceinline__ void stage_rc(int b, int& R, int& C) { const int st = b / 1024, sb = b % 1024, swz = sb ^ (((sb >> 9) & 1) << 5); R = (st >> 1) * 16 + swz / 64; C = (st & 1) * 32 + (swz % 64) / 2; }
__host__ __device__ __forceinline__ int perm32(int rho) { const int n = rho >> 4, i = rho & 15; return 8 * (i >> 2) + 4 * n + (i & 3); }

struct Unit { int pm, pn; };
struct Gemm { const bf16_t* A; const bf16_t* Bt; int M, N, K; };

struct StaticOrder {
    int nM, nN, nwg, G, c;
    __host__ __device__ void init(int M, int N, int G_, int c_) { nM = M / BM; nN = N / BM; nwg = nM * nN; G = G_; c = c_; }
    __host__ __device__ bool next(int i, Unit& u) const {
        const long L = (long)i * G + c; if (L >= nwg) return false;
        int wgid = (int)L; { const int q = nwg / NXCD, r = nwg % NXCD, xcd = wgid % NXCD, off = wgid / NXCD; wgid = (xcd < r ? xcd * (q + 1) : r * (q + 1) + (xcd - r) * q) + off; }
        const int nig = WGM * nN, gid = wgid / nig, fm = gid * WGM, gsz = (nM - fm) < WGM ? (nM - fm) : WGM;
        u.pm = fm + ((wgid % nig) % gsz); u.pn = (wgid % nig) / gsz; return true;
    }
    __device__ __forceinline__ void a_ready(const Unit&) const {}
    __device__ __forceinline__ void done(const Unit&) const {}
};

__device__ __forceinline__ unsigned cvt_pk_bf16(float lo, float hi) { unsigned r; asm volatile("v_cvt_pk_bf16_f32 %0, %1, %2" : "=v"(r) : "v"(lo), "v"(hi)); return r; }
typedef float f32x2 __attribute__((ext_vector_type(2)));
constexpr int MPROMPT = 16384;
constexpr size_t PO_YP = 0, PO_YS = PO_YP + (size_t)16384 * 1024, PO_NSAP = PO_YS + (size_t)512 * 1024, PO_NSAS = PO_NSAP + (size_t)2 * 16384 * 512, PO_WINP = PO_NSAS + (size_t)2 * 512 * 512,
                 PO_WINS = PO_WINP + (size_t)2 * 2 * 512 * 256, PO_GV = PO_WINS + (size_t)2 * 512 * 256, PO_HP = PO_GV + (size_t)2 * 512 * 512, PO_HS = PO_HP + (size_t)2 * 2 * 1024,
                 PO_CVP = PO_HS + (size_t)2 * 128 * 1024, PO_CVS = PO_CVP + (size_t)2 * 2 * 3 * 1024;
__device__ __forceinline__ float row_rinv(const float* ssq, int row) {
    const f32x4* p = (const f32x4*)(ssq + (size_t)row * 16);
    const f32x4 a = p[0], b = p[1], c = p[2], d = p[3];
    const float s = ((a[0] + a[1]) + (a[2] + a[3])) + ((b[0] + b[1]) + (b[2] + b[3])) + ((c[0] + c[1]) + (c[2] + c[3])) + ((d[0] + d[1]) + (d[2] + d[3]));
    return rsqrtf(s * (1.0f / 1024.0f) + 1e-6f);
}
constexpr size_t PW_KSLC = (size_t)44 << 20, PW_VSLC = (size_t)48 << 20, PW_KWIN = (size_t)52 << 20, PW_VWIN = (size_t)56 << 20, PW_MEAN = (size_t)132 << 20;
constexpr int VT_WAVE = 2560, VT_LD = 40;
template <int CTRL> __device__ __forceinline__ float dppf(float x) { return __builtin_bit_cast(float, __builtin_amdgcn_mov_dpp(__builtin_bit_cast(int, x), CTRL, 0xf, 0xf, true)); }
__device__ __forceinline__ float row16_sum(float x) { x += dppf<0xB1>(x); x += dppf<0x4E>(x); x += dppf<0x124>(x); x += dppf<0x128>(x); return x; }
constexpr int RINV_OFF = 8 * VT_WAVE;
__device__ __forceinline__ void unit_rinv(float (&ris)[2][4], const float* ssq, __attribute__((address_space(3))) unsigned char* vt, const Unit& u, int wr, int wc, int fr, int fq) {
    typedef __attribute__((address_space(3))) float lds_f32;
    lds_f32* rl = (lds_f32*)(vt + RINV_OFF) + wr * 128;
    const int lane = fr + 16 * fq;
    if (lane < 32) { const int q = wc * 32 + lane; rl[q] = row_rinv(ssq, u.pm * BM + (q >> 6) * HALF + wr * 64 + (q & 63)); }
    asm volatile("s_waitcnt lgkmcnt(0)" ::: "memory"); __builtin_amdgcn_s_barrier(); asm volatile("" ::: "memory");
#pragma unroll
    for (int ai = 0; ai < 2; ++ai)
#pragma unroll
        for (int m = 0; m < 4; ++m) ris[ai][m] = rl[ai * 64 + m * 16 + fr];
}
struct EpiInA {
    static constexpr bool PERM = true, AFTER_DRAIN = false;
    bf16_t* proj; const float* ssq; float* out; int L;
    unsigned char* ws; __attribute__((address_space(3))) unsigned char* vt;
    __device__ __forceinline__ void operator()(const f32x4 (&acc)[2][2][4][2], const Unit& u, int wr, int wc, int fr, int fq) const {
        typedef __attribute__((address_space(3))) unsigned short lds_u16; typedef __attribute__((address_space(3))) u32x4 lds_u32x4;
        const int row0 = u.pm * BM + wr * 64 + fr, colt = u.pn * BM + wc * 32 + 8 * fq;
        const bool pr = u.pm < MPROMPT / BM, kvt = pr && (u.pn == 3 || u.pn == 4), cmt = pr && u.pn == 2, keep = !(pr && u.pn >= 2 && u.pn <= 4);
        const int g = wc >> 1, lane = fr + 16 * fq;
        float risu[2][4]; unit_rinv(risu, ssq, vt, u, wr, wc, fr, fq);
#pragma unroll
        for (int ai = 0; ai < 2; ++ai) {
            const int rb = u.pm * BM + ai * HALF + wr * 64, bb = rb >> 13, blk = (rb >> 6) & 127;
            f32x4 cs[2][2]; float ris[4];
#pragma unroll
            for (int bj = 0; bj < 2; ++bj) { cs[bj][0] = (f32x4){0.f, 0.f, 0.f, 0.f}; cs[bj][1] = (f32x4){0.f, 0.f, 0.f, 0.f}; }
#pragma unroll
            for (int m = 0; m < 4; ++m) {
                const int row = row0 + ai * HALF + m * 16; const float ri = risu[ai][m]; ris[m] = ri;
                bf16_t* rowp = proj + (size_t)row * 3584 + colt;
#pragma unroll
                for (int bj = 0; bj < 2; ++bj) {
                    const f32x4 v0 = acc[ai][bj][m][0] * ri, v1 = acc[ai][bj][m][1] * ri;
                    u32x4 w; w.x = cvt_pk_bf16(v0[0], v0[1]); w.y = cvt_pk_bf16(v0[2], v0[3]); w.z = cvt_pk_bf16(v1[0], v1[1]); w.w = cvt_pk_bf16(v1[2], v1[3]);
                    if (keep) *(u32x4*)(rowp + bj * HALF) = w;
                    if (u.pn == 2 || u.pn == 3) {
                        const int kc = (u.pn - 2) * 256 + bj * HALF + wc * 32 + 8 * fq;
                        float* o = out + ((row < MPROMPT) ? PO_NSAP + ((size_t)L * MPROMPT + row) * 512 + kc : PO_NSAS + ((size_t)L * 512 + (row - MPROMPT)) * 512 + kc);
                        __builtin_nontemporal_store(v0, (f32x4*)o); __builtin_nontemporal_store(v1, (f32x4*)(o + 4));
                    } else if (u.pn == 4) {
                        const int kc = bj * HALF + wc * 32 + 8 * fq;
                        if (row < MPROMPT) { const int b = row >> 13, t = row & 8191;
                            if (t >= 8192 - 512) { float* o = out + PO_WINP + (((size_t)L * 2 + b) * 512 + (t - (8192 - 512))) * 256 + kc; __builtin_nontemporal_store(v0, (f32x4*)o); __builtin_nontemporal_store(v1, (f32x4*)(o + 4)); } }
                        else { float* o = out + PO_WINS + ((size_t)L * 512 + (row - MPROMPT)) * 256 + kc; __builtin_nontemporal_store(v0, (f32x4*)o); __builtin_nontemporal_store(v1, (f32x4*)(o + 4)); }
                    }
                    if (kvt && bj == 0)
                        *((u32x4*)(ws + (u.pn == 3 ? PW_KSLC : PW_KWIN)) + ((size_t)((bb * 2 + g) * 128 + blk)) * 512 + (m * 2 + (wc & 1)) * 64 + lane) = w;
                    if (cmt) { cs[bj][0] += v0; cs[bj][1] += v1; }
                }
            }
            if (cmt) {
#pragma unroll
                for (int bj = 0; bj < 2; ++bj) {
#pragma unroll
                    for (int n = 0; n < 2; ++n)
#pragma unroll
                        for (int i = 0; i < 4; ++i) cs[bj][n][i] = row16_sum(cs[bj][n][i]) * (1.0f / 64.0f);
                    if (fr == 0) { float* mp = (float*)(ws + PW_MEAN) + ((((size_t)(bb * 128 + blk) * 2 + bj) * 2 + g) * 64 + (wc & 1) * 32 + 8 * fq); *(f32x4*)mp = cs[bj][0]; *(f32x4*)(mp + 4) = cs[bj][1]; }
                }
            }
            if (kvt) {
                lds_u16* tile = (lds_u16*)(vt + (wr * 4 + wc) * VT_WAVE);
                u32x4* dstv = (u32x4*)(ws + (u.pn == 3 ? PW_VSLC : PW_VWIN)) + ((size_t)((bb * 2 + g) * 128 + blk)) * 512;
#pragma unroll
                for (int ks2 = 0; ks2 < 2; ++ks2) {
#pragma unroll
                    for (int mm = 0; mm < 2; ++mm) { const int m = 2 * ks2 + mm; const f32x4 v0 = acc[ai][1][m][0] * ris[m], v1 = acc[ai][1][m][1] * ris[m];
                        u32x4 w; w.x = cvt_pk_bf16(v0[0], v0[1]); w.y = cvt_pk_bf16(v0[2], v0[3]); w.z = cvt_pk_bf16(v1[0], v1[1]); w.w = cvt_pk_bf16(v1[2], v1[3]);
                        *(lds_u32x4*)(tile + (mm * 16 + fr) * VT_LD + 8 * fq) = w; }
                    asm volatile("s_waitcnt lgkmcnt(0)" ::: "memory");
#pragma unroll
                    for (int dtl = 0; dtl < 2; ++dtl) { unsigned short v[8];
#pragma unroll
                        for (int e = 0; e < 8; ++e) v[e] = tile[((e >> 2) * 16 + fq * 4 + (e & 3)) * VT_LD + dtl * 16 + fr];
                        u32x4 o; o.x = v[0] | ((unsigned)v[1] << 16); o.y = v[2] | ((unsigned)v[3] << 16); o.z = v[4] | ((unsigned)v[5] << 16); o.w = v[6] | ((unsigned)v[7] << 16);
                        dstv[((2 * (wc & 1) + dtl) * 2 + ks2) * 64 + lane] = o; }
                    asm volatile("s_waitcnt lgkmcnt(0)" ::: "memory");
                }
            }
        }
    }
};
struct EpiInC {
    static constexpr bool PERM = true, AFTER_DRAIN = false;
    bf16_t* xbz; const float* ssq; float* out; int L; __attribute__((address_space(3))) unsigned char* vt;
    __device__ __forceinline__ void operator()(const f32x4 (&acc)[2][2][4][2], const Unit& u, int wr, int wc, int fr, int fq) const {
        const int row0 = u.pm * BM + wr * 64 + fr, colt = u.pn * BM + wc * 32 + 8 * fq;
        float risu[2][4]; unit_rinv(risu, ssq, vt, u, wr, wc, fr, fq);
#pragma unroll
        for (int ai = 0; ai < 2; ++ai)
#pragma unroll
            for (int m = 0; m < 4; ++m) {
                const int row = row0 + ai * HALF + m * 16; const float ri = risu[ai][m];
                bf16_t* rowp = xbz + (size_t)row * 2048 + colt;
                float* o = nullptr;
                if (u.pn < 4) {
                    if (row < MPROMPT) { const int b = row >> 13, t = row & 8191; if (t >= 8192 - 3) o = out + PO_CVP + (((size_t)L * 2 + b) * 3 + (t - (8192 - 3))) * 1024 + colt; }
                    else { const int s = (row - MPROMPT) >> 2, t = (row - MPROMPT) & 3; if (t >= 1) o = out + PO_CVS + (((size_t)L * 128 + s) * 3 + (t - 1)) * 1024 + colt; }
                }
#pragma unroll
                for (int bj = 0; bj < 2; ++bj) {
                    const f32x4 v0 = acc[ai][bj][m][0] * ri, v1 = acc[ai][bj][m][1] * ri;
                    u32x4 w; w.x = cvt_pk_bf16(v0[0], v0[1]); w.y = cvt_pk_bf16(v0[2], v0[3]); w.z = cvt_pk_bf16(v1[0], v1[1]); w.w = cvt_pk_bf16(v1[2], v1[3]);
                    *(u32x4*)(rowp + bj * HALF) = w;
                    if (o) { *(f32x4*)(o + bj * HALF) = v0; *(f32x4*)(o + bj * HALF + 4) = v1; }
                }
            }
    }
};
struct EpiRes {
    static constexpr bool PERM = true, AFTER_DRAIN = false;
    bf16_t* r; float* ssq;
    __device__ __forceinline__ void operator()(const f32x4 (&acc)[2][2][4][2], const Unit& u, int wr, int wc, int fr, int fq) const {
        typedef __attribute__((address_space(1))) unsigned char gbyte; typedef __attribute__((address_space(1))) u32x4 g_u32x4;
        const int row0 = u.pm * BM + wr * 64 + fr, colt = u.pn * BM + wc * 32 + 8 * fq;
        gbyte* rb = (gbyte*)(unsigned long long)r;
        const unsigned off0 = ((unsigned)row0 * 1024u + (unsigned)colt) * 2u;
        u32x4 qr[2][4][2];
#pragma unroll
        for (int ai = 0; ai < 2; ++ai)
#pragma unroll
            for (int m = 0; m < 4; ++m)
#pragma unroll
                for (int bj = 0; bj < 2; ++bj) qr[ai][m][bj] = *(const g_u32x4*)(rb + (off0 + (unsigned)((ai * HALF + m * 16) * 2048 + bj * HALF * 2)));
#pragma unroll
        for (int ai = 0; ai < 2; ++ai)
#pragma unroll
            for (int m = 0; m < 4; ++m) {
                const int row = row0 + ai * HALF + m * 16;
                float ss = 0.f;
#pragma unroll
                for (int bj = 0; bj < 2; ++bj) {
                    const u32x4 q = qr[ai][m][bj];
                    const f32x4 r0 = {__builtin_bit_cast(float, q.x << 16), __builtin_bit_cast(float, q.x & 0xffff0000u), __builtin_bit_cast(float, q.y << 16), __builtin_bit_cast(float, q.y & 0xffff0000u)};
                    const f32x4 r1 = {__builtin_bit_cast(float, q.z << 16), __builtin_bit_cast(float, q.z & 0xffff0000u), __builtin_bit_cast(float, q.w << 16), __builtin_bit_cast(float, q.w & 0xffff0000u)};
                    const f32x4 v0 = acc[ai][bj][m][0] + r0, v1 = acc[ai][bj][m][1] + r1;
                    ss += ((v0[0] * v0[0] + v0[1] * v0[1]) + (v0[2] * v0[2] + v0[3] * v0[3])) + ((v1[0] * v1[0] + v1[1] * v1[1]) + (v1[2] * v1[2] + v1[3] * v1[3]));
                    u32x4 w; w.x = cvt_pk_bf16(v0[0], v0[1]); w.y = cvt_pk_bf16(v0[2], v0[3]); w.z = cvt_pk_bf16(v1[0], v1[1]); w.w = cvt_pk_bf16(v1[2], v1[3]);
                    *(g_u32x4*)(rb + (off0 + (unsigned)((ai * HALF + m * 16) * 2048 + bj * HALF * 2))) = w;
                }
                ss += __shfl_xor(ss, 16); ss += __shfl_xor(ss, 32);
                if (fq == 0) ssq[(size_t)row * 16 + u.pn * 4 + wc] = ss;
            }
    }
};
template <class Epi, class Sched, bool ALIGN_EPI = false, bool SP2 = false>
__device__ __forceinline__ void gemm_phase(PG8_LAS unsigned char* lds, const Gemm g, const Sched& S, const Epi& E, int wave_in  ) {
    int tid_; asm volatile("v_mbcnt_lo_u32_b32 %0, -1, 0\n\tv_mbcnt_hi_u32_b32 %0, -1, %0" : "=v"(tid_)); tid_ += wave_in * 64;
    const int tid = tid_, wid = __builtin_amdgcn_readfirstlane(tid >> 6), lane = tid & 63, wr = wid >> 2, wc = wid & 3, fr = lane & 15, fq = lane >> 4;
    const int K = g.K, nt = K / BK;
    unsigned voffA[2], voffB[2];
#pragma unroll
    for (int i = 0; i < 2; ++i) { int R, C; stage_rc(tid * 16 + i * 8192, R, C); const int Rb = Epi::PERM ? ((R & ~31) + perm32(R & 31)) : R;
        voffA[i] = (unsigned)(R * K + C) * 2u; voffB[i] = (unsigned)(Rb * K + C) * 2u; }
    const size_t kstep = (size_t)(BK * 2);
    const size_t hstep = (size_t)HALF * K * 2;
    const size_t tstep = 2 * hstep;
    const unsigned ldsw = (unsigned)wid * 1024u;
    const int aoff = lds_byte(wr * 64 + fr, fq * 8), boff = lds_byte(wc * 32 + fr, fq * 8);
#define PG8_SA(b, h) (((b) * 2 + (h)) * HTB)
#define PG8_SB(b, h) ((4 + (b) * 2 + (h)) * HTB)
#define PG8_STAGE(bufoff, gbase, voff) do { _Pragma("unroll") for (int _i = 0; _i < 2; ++_i) \
        __builtin_amdgcn_global_load_lds((const unsigned*)((const char*)(gbase) + (voff)[_i]), (PG8_LAS unsigned*)(lds + (bufoff) + ldsw + _i * 8192), 16, 0, 0); } while (0)
#define PG8_LDA(dst, b, h) do { _Pragma("unroll") for (int m = 0; m < 4; ++m) _Pragma("unroll") for (int k = 0; k < 2; ++k) dst[m][k] = *(const PG8_LAS bf16x8*)(lds + PG8_SA(b, h) + aoff + m * 2048 + k * 1024); } while (0)
#define PG8_LDB(dst, b, h) do { _Pragma("unroll") for (int n = 0; n < 2; ++n) _Pragma("unroll") for (int k = 0; k < 2; ++k) dst[n][k] = *(const PG8_LAS bf16x8*)(lds + PG8_SB(b, h) + boff + n * 2048 + k * 1024); } while (0)
#define PG8_MMA(ai, bj, At, Bt) do { __builtin_amdgcn_s_setprio(1); _Pragma("unroll") for (int m = 0; m < 4; ++m) _Pragma("unroll") for (int n = 0; n < 2; ++n) _Pragma("unroll") for (int k = 0; k < 2; ++k) \
        acc[ai][bj][m][n] = __builtin_amdgcn_mfma_f32_16x16x32_bf16(Bt[n][k], At[m][k], acc[ai][bj][m][n], 0, 0, 0); __builtin_amdgcn_s_setprio(0); } while (0)
#define PG8_WAIT_V(n) asm volatile("s_waitcnt vmcnt(" #n ")" ::: "memory")
#define PG8_WAIT_L(n) asm volatile("s_waitcnt lgkmcnt(" #n ")" ::: "memory")
#define PG8_BAR __builtin_amdgcn_s_barrier()
#define PG8_SCHED __builtin_amdgcn_sched_barrier(0)
    Unit cur, nxt; int ui = 0;
    if (!S.next(0, cur)) return;
    f32x4 acc[2][2][4][2];
#pragma unroll
    for (int a = 0; a < 2; ++a)
#pragma unroll
        for (int b = 0; b < 2; ++b)
#pragma unroll
            for (int m = 0; m < 4; ++m)
#pragma unroll
                for (int n = 0; n < 2; ++n) acc[a][b][m][n] = (f32x4){0.f, 0.f, 0.f, 0.f};
    bf16x8 At[4][2], B0[2][2], B1[2][2];
    const char* cA = (const char*)g.A + (size_t)cur.pm * tstep; const char* cB = (const char*)g.Bt + (size_t)cur.pn * tstep;
    S.a_ready(cur);
    if constexpr (SP2) {
        PG8_STAGE(PG8_SB(0, 0), cB, voffB); PG8_STAGE(PG8_SB(0, 1), cB + hstep, voffB); PG8_STAGE(PG8_SA(0, 0), cA, voffA); PG8_STAGE(PG8_SA(0, 1), cA + hstep, voffA);
        if (wr == 1) PG8_BAR;
        PG8_WAIT_V(2); PG8_BAR;
        PG8_STAGE(PG8_SB(1, 0), cB + kstep, voffB); PG8_STAGE(PG8_SA(1, 0), cA + kstep, voffA); PG8_STAGE(PG8_SB(1, 1), cB + hstep + kstep, voffB);
        PG8_WAIT_V(6); PG8_BAR;
    } else {
        PG8_STAGE(PG8_SB(0, 0), cB, voffB); PG8_STAGE(PG8_SA(0, 0), cA, voffA); PG8_STAGE(PG8_SB(0, 1), cB + hstep, voffB); PG8_STAGE(PG8_SA(0, 1), cA + hstep, voffA);
        if (wr == 1) PG8_BAR;
        PG8_WAIT_V(4); PG8_BAR;
        PG8_STAGE(PG8_SB(1, 0), cB + kstep, voffB); PG8_STAGE(PG8_SA(1, 0), cA + kstep, voffA); PG8_STAGE(PG8_SB(1, 1), cB + hstep + kstep, voffB);
        PG8_WAIT_V(6); PG8_BAR;
    }
    for (;;) {
        const bool has_next = S.next(ui + 1, nxt);
        const char* nA = has_next ? (const char*)g.A + (size_t)nxt.pm * tstep : cA; const char* nB = has_next ? (const char*)g.Bt + (size_t)nxt.pn * tstep : cB;
        for (int t = 0; t < nt; t += 2) {
            const bool last = (t == nt - 2);
            const char* a1 = cA + (size_t)(t + 1) * kstep;
            const char* a2 = last ? nA : cA + (size_t)(t + 2) * kstep; const char* b2 = last ? nB : cB + (size_t)(t + 2) * kstep;
            const char* a3 = a2 + kstep; const char* b3 = b2 + kstep;
            if (last && has_next) S.a_ready(nxt);
            if constexpr (SP2) {
            PG8_LDB(B0, 0, 0); PG8_LDB(B1, 0, 1); PG8_SCHED; PG8_LDA(At, 0, 0); PG8_STAGE(PG8_SA(1, 1), a1 + hstep, voffA);
            PG8_WAIT_V(8); PG8_WAIT_L(0); PG8_BAR; PG8_MMA(0, 0, At, B0); PG8_MMA(0, 1, At, B1); PG8_BAR; PG8_SCHED;
            PG8_LDA(At, 0, 1); PG8_STAGE(PG8_SB(0, 0), b2, voffB); PG8_STAGE(PG8_SB(0, 1), b2 + hstep, voffB); PG8_STAGE(PG8_SA(0, 0), a2, voffA);
            PG8_WAIT_V(8); PG8_WAIT_L(0); PG8_BAR; PG8_MMA(1, 0, At, B0); PG8_MMA(1, 1, At, B1); PG8_BAR; PG8_SCHED;
            PG8_LDB(B0, 1, 0); PG8_LDB(B1, 1, 1); PG8_SCHED; PG8_LDA(At, 1, 0); PG8_STAGE(PG8_SA(0, 1), a2 + hstep, voffA);
            PG8_WAIT_V(8); PG8_WAIT_L(0); PG8_BAR; PG8_MMA(0, 0, At, B0); PG8_MMA(0, 1, At, B1); PG8_BAR; PG8_SCHED;
            PG8_LDA(At, 1, 1); PG8_STAGE(PG8_SB(1, 0), b3, voffB); PG8_STAGE(PG8_SB(1, 1), b3 + hstep, voffB); PG8_STAGE(PG8_SA(1, 0), a3, voffA);
            PG8_WAIT_V(8); PG8_WAIT_L(0); PG8_BAR; PG8_MMA(1, 0, At, B0); PG8_MMA(1, 1, At, B1); PG8_BAR; PG8_SCHED;
            } else {
            PG8_LDB(B0, 0, 0); PG8_SCHED; PG8_LDA(At, 0, 0); PG8_STAGE(PG8_SA(1, 1), a1 + hstep, voffA);
            PG8_WAIT_L(8); PG8_BAR; PG8_WAIT_L(0); PG8_MMA(0, 0, At, B0); PG8_BAR; PG8_SCHED;
            PG8_LDB(B1, 0, 1); PG8_STAGE(PG8_SB(0, 0), b2, voffB);
            PG8_BAR; PG8_WAIT_L(0); PG8_MMA(0, 1, At, B1); PG8_BAR;
            PG8_LDA(At, 0, 1); PG8_STAGE(PG8_SA(0, 0), a2, voffA);
            PG8_BAR; PG8_WAIT_L(0); PG8_MMA(1, 0, At, B0); PG8_BAR; PG8_SCHED;
            PG8_STAGE(PG8_SB(0, 1), b2 + hstep, voffB);
            PG8_WAIT_V(6); PG8_BAR; PG8_MMA(1, 1, At, B1); PG8_BAR;
            PG8_LDB(B0, 1, 0); PG8_SCHED; PG8_LDA(At, 1, 0); PG8_STAGE(PG8_SA(0, 1), a2 + hstep, voffA);
            PG8_WAIT_L(8); PG8_BAR; PG8_WAIT_L(0); PG8_MMA(0, 0, At, B0); PG8_BAR; PG8_SCHED;
            PG8_LDB(B1, 1, 1); PG8_STAGE(PG8_SB(1, 0), b3, voffB);
            PG8_BAR; PG8_WAIT_L(0); PG8_MMA(0, 1, At, B1); PG8_BAR;
            PG8_LDA(At, 1, 1); PG8_STAGE(PG8_SA(1, 0), a3, voffA);
            PG8_BAR; PG8_WAIT_L(0); PG8_MMA(1, 0, At, B0); PG8_BAR; PG8_SCHED;
            PG8_STAGE(PG8_SB(1, 1), b3 + hstep, voffB);
            PG8_WAIT_V(6); PG8_BAR; PG8_MMA(1, 1, At, B1); PG8_BAR;
            }
        }
        if constexpr (ALIGN_EPI) { if (wr == 0) PG8_BAR; }
        if constexpr (!Epi::AFTER_DRAIN) { E(acc, cur, wr, wc, fr, fq); S.done(cur); }
        if (!has_next) break;
#pragma unroll
        for (int a = 0; a < 2; ++a)
#pragma unroll
            for (int b = 0; b < 2; ++b)
#pragma unroll
                for (int m = 0; m < 4; ++m)
#pragma unroll
                    for (int n = 0; n < 2; ++n) acc[a][b][m][n] = (f32x4){0.f, 0.f, 0.f, 0.f};
        cur = nxt; cA = nA; cB = nB; ++ui;
        if constexpr (ALIGN_EPI) { if (wr == 1) PG8_BAR; }
    }
    PG8_WAIT_V(0);
    if constexpr (!ALIGN_EPI) { if (wr == 0) PG8_BAR; }
    PG8_BAR;
    if constexpr (Epi::AFTER_DRAIN) { E.fused(acc, cur, wr, wc, fr, fq, lds, wid, lane); S.done(cur); }
#undef PG8_SA
#undef PG8_SB
#undef PG8_STAGE
#undef PG8_LDA
#undef PG8_LDB
#undef PG8_MMA
#undef PG8_WAIT_V
#undef PG8_WAIT_L
#undef PG8_BAR
#undef PG8_SCHED
}
}
constexpr int NWAVES = 8;
constexpr int D = 1024, BATCH = 2, T = 8192, MP = BATCH * T, DEC_B = 128, DEC_T = 4, MS = DEC_B * DEC_T, M = MP + MS;
constexpr int NPA = 3584;
constexpr int CQ = 0, CKV = 512, CGATE = 1280, CZN = 1536, CU = 2048, CV = 2560, CZG = 3072;
constexpr int PROJ_A = 3352, N_POOL = 2560, NPAGES = 16, PAST = 2048;
constexpr float EPS = 1e-6f;
constexpr float SCL = 0.18033688011112042f;
constexpr float LOG2E = 1.4426950408889634f;

constexpr size_t MiB = 1u << 20;
constexpr size_t WS_CTL = 0, CTL_ZERO_BYTES = 1 * MiB;
constexpr size_t WS_WINA = 2 * MiB, WS_WOUTA = 16 * MiB, WS_WINC = 20 * MiB, WS_WOUTC = 28 * MiB, WS_WG = 32 * MiB, WS_WSP = 33 * MiB;
constexpr size_t WS_SSQ = 34 * MiB, WS_LSUM = 36 * MiB, WS_CARRY = 38 * MiB;
constexpr size_t WS_KCF = 40 * MiB, WS_VCF = 40 * MiB + 256 * 1024, WS_KCFS = 41 * MiB, WS_VCFS = 42 * MiB;
constexpr size_t WS_KSLC = 44 * MiB, WS_VSLC = 48 * MiB, WS_KWIN = 52 * MiB, WS_VWIN = 56 * MiB;
constexpr size_t WS_XG = 64 * MiB, WS_ACT2 = 98 * MiB, WS_Y = 132 * MiB, WS_MEAN = WS_Y  , WS_PEM = WS_Y + MiB  , WS_PROJ = 200 * MiB, WS_ATTPRE = 320 * MiB, WS_HP = 336 * MiB, WS_END = 400 * MiB;
static_assert(WS_XG + (size_t)M * D * 2 <= WS_ACT2 && WS_ACT2 + (size_t)M * D * 2 <= WS_Y && WS_Y + (size_t)M * D * 4 <= WS_PROJ && WS_PROJ + (size_t)M * NPA * 2 <= WS_ATTPRE, "d_ws map");
constexpr int CW_TMO = 0;
constexpr int CW_BAR = 4096;
constexpr int CW_GQ = 8192;

constexpr int RING_OFF = 0, RING_BYTES = 131072, SCRATCH_BYTES = 159744;
constexpr int LDSCTL_OFF = SCRATCH_BYTES, MISC_OFF = LDSCTL_OFF + 320;
constexpr int PTR_OFF = LDSCTL_OFF + 1024;
constexpr int LDS_BYTES = 163840;

#define GAS __attribute__((address_space(1)))
#define LAS __attribute__((address_space(3)))
typedef unsigned short bf16;
typedef unsigned v4u __attribute__((ext_vector_type(4)));
typedef unsigned v2u __attribute__((ext_vector_type(2)));
typedef float f32x4 __attribute__((ext_vector_type(4)));
typedef short bf16x8 __attribute__((ext_vector_type(8)));
typedef GAS unsigned gu32;
#define RLX_AGENT __ATOMIC_RELAXED, __HIP_MEMORY_SCOPE_AGENT
#define LDS_WAIT() asm volatile("s_waitcnt lgkmcnt(0)" ::: "memory")
#define VM_WAIT() asm volatile("s_waitcnt vmcnt(0)" ::: "memory")
#define LDS_BARRIER() do { asm volatile("s_waitcnt lgkmcnt(0)" ::: "memory"); __builtin_amdgcn_s_barrier(); asm volatile("" ::: "memory"); } while (0)
__device__ __forceinline__ unsigned f2bf(float f) { unsigned u = __builtin_bit_cast(unsigned, f); return (u + 0x7fffu + ((u >> 16) & 1u)) >> 16; }
__device__ __forceinline__ unsigned pk2(float lo, float hi) { return pg8::cvt_pk_bf16(lo, hi); }
__device__ __forceinline__ float bf2f(unsigned short v) { return __builtin_bit_cast(float, (unsigned)v << 16); }
__device__ __forceinline__ float bflo(unsigned w) { return __builtin_bit_cast(float, w << 16); }
__device__ __forceinline__ float bfhi(unsigned w) { return __builtin_bit_cast(float, w & 0xffff0000u); }
__device__ __forceinline__ float fexp2(float x) { return __builtin_amdgcn_exp2f(x); }
__device__ __forceinline__ float fsigmoid(float x) { return __builtin_amdgcn_rcpf(1.0f + fexp2(-x * LOG2E)); }
__device__ __forceinline__ float fsilu(float x) { return x * fsigmoid(x); }
__device__ __forceinline__ f32x4 mfma16(bf16x8 a, bf16x8 b, f32x4 c) { return __builtin_amdgcn_mfma_f32_16x16x32_bf16(a, b, c, 0, 0, 0); }
__device__ __forceinline__ bf16x8 pack8(const f32x4 a, const f32x4 b) { v4u w; w.x = pk2(a[0], a[1]); w.y = pk2(a[2], a[3]); w.z = pk2(b[0], b[1]); w.w = pk2(b[2], b[3]); return __builtin_bit_cast(bf16x8, w); }
__device__ __forceinline__ bf16x8 zero8() { v4u w = {0u, 0u, 0u, 0u}; return __builtin_bit_cast(bf16x8, w); }
__device__ __forceinline__ float wave_sum(float v) {
#pragma unroll
    for (int o = 1; o < 64; o <<= 1) v += __shfl_xor(v, o);
    return v;
}
__device__ __forceinline__ int rel_bucket(int d) {
    if (d < 16) return d;
    int b = 16;
    b += (d >= 21); b += (d >= 27); b += (d >= 35); b += (d >= 46); b += (d >= 59); b += (d >= 77); b += (d >= 99); b += (d >= 128);
    b += (d >= 166); b += (d >= 216); b += (d >= 280); b += (d >= 363); b += (d >= 470); b += (d >= 609); b += (d >= 790);
    return b;
}

#define XB_TMO      128
#define XB_XCNT(j)  (256  + 64 * (j))
#define XB_XSUB(j)  (1280 + 64 * (j))
#define XB_XGEN(j)  (2304 + 64 * (j))
#define XB_TOP      3328
#define XB_TOPGEN   3392
#define XCD_BAR_WORDS 3456
#define XB_SPIN_CAP (1u << 18)

__device__ __forceinline__ unsigned xb_ld(unsigned* p)              { return __hip_atomic_load(p, __ATOMIC_RELAXED, __HIP_MEMORY_SCOPE_AGENT); }
__device__ __forceinline__ unsigned xb_add(unsigned* p, unsigned v) { return __hip_atomic_fetch_add(p, v, __ATOMIC_RELAXED, __HIP_MEMORY_SCOPE_AGENT); }
__device__ __forceinline__ unsigned xb_xcc_id() { return (unsigned)__builtin_amdgcn_s_getreg((3 << 11) | 20) & 0xFu; }
#define XB_SPIN(cond, bar) do { unsigned _sp = 0; while (cond) { __builtin_amdgcn_s_sleep(1); \
    if ((++_sp & 255u) == 0u) { if (xb_ld(&(bar)[XB_TMO])) break; if (_sp > XB_SPIN_CAP) { atomicAdd(&(bar)[XB_TMO], 1u); break; } } } } while (0)

struct XcdBarrier {
    unsigned* bar; unsigned x;
    volatile LAS unsigned* st;
    bool w0;
};
__device__ __forceinline__ bool xb_leader(const XcdBarrier& b) { unsigned l_; asm volatile("v_mbcnt_lo_u32_b32 %0, -1, 0\n\tv_mbcnt_hi_u32_b32 %0, -1, %0" : "=v"(l_)); return b.w0 && l_ == 0u; }

__device__ __forceinline__ XcdBarrier xcd_barrier_post(unsigned* bar, volatile LAS unsigned* st, bool w0) {
    XcdBarrier b; b.bar = bar; b.x = xb_xcc_id(); b.st = st; b.w0 = w0;
    if (xb_leader(b)) (void)xb_add(&bar[XB_XCNT(b.x)], 1u);
    return b;
}
__device__ __forceinline__ void xcd_barrier_complete(unsigned* bar, unsigned x, unsigned& nloc, unsigned& nx) {
    const unsigned G = gridDim.x * gridDim.y * gridDim.z;
    unsigned sum, cnt, mine, sp = 0u;
    for (;;) {
        sum = 0u; cnt = 0u; mine = 0u;
#pragma unroll
        for (unsigned j = 0; j < 16; ++j) { const unsigned c = xb_ld(&bar[XB_XCNT(j)]); sum += c; cnt += (c > 0u) ? 1u : 0u; mine = (j == x) ? c : mine; }
        if (sum == G) break;
        __builtin_amdgcn_s_sleep(1);
        if ((++sp & 255u) == 0u) { if (xb_ld(&bar[XB_TMO])) break; if (sp > XB_SPIN_CAP) { atomicAdd(&bar[XB_TMO], 1u); break; } }
    }
    nloc = mine > 0u ? mine : 1u; nx = cnt > 0u ? cnt : 1u;
}

__device__ __forceinline__ void xcd_barrier(const XcdBarrier& b) {
    asm volatile("s_waitcnt vmcnt(0)" ::: "memory");
    __syncthreads();
    if (xb_leader(b)) {
        unsigned* bar = b.bar;
        __builtin_amdgcn_s_waitcnt(0);
        unsigned nloc = b.st[0], nx = b.st[1];
        if (nloc == 0u) { xcd_barrier_complete(bar, b.x, nloc, nx); b.st[0] = nloc; b.st[1] = nx; }
        const unsigned old = xb_add(&bar[XB_XSUB(b.x)], 1u);
        const unsigned gen = old / nloc;
        if (old + 1u == (gen + 1u) * nloc) {
            __builtin_amdgcn_fence(__ATOMIC_RELEASE, "agent");
            asm volatile("s_waitcnt vmcnt(0)" ::: "memory");
            const unsigned og = xb_add(&bar[XB_TOP], 1u);
            const unsigned tg = og / nx;
            if (og + 1u == (tg + 1u) * nx) xb_add(&bar[XB_TOPGEN], 1u);
            else XB_SPIN(xb_ld(&bar[XB_TOPGEN]) == tg, bar);
            __builtin_amdgcn_fence(__ATOMIC_ACQUIRE, "agent");
            xb_add(&bar[XB_XGEN(b.x)], 1u);
            asm volatile("s_waitcnt vmcnt(0)" ::: "memory");
        } else {
            XB_SPIN(xb_ld(&bar[XB_XGEN(b.x)]) == gen, bar);
            __builtin_amdgcn_fence(__ATOMIC_ACQUIRE, "agent");
            asm volatile("s_waitcnt vmcnt(0)" ::: "memory");
        }
    }
    __syncthreads();
}

struct Args { const void* in[29]; float* out; unsigned char* ws; int ph_lo, ph_hi, use_bar, pad; };
struct Frame {
    LAS unsigned char* lds;
    volatile LAS unsigned* MISC;
    gu32* ctl;
    int tid, lane, wave;
    int vcu, G;
    unsigned char* ws; float* out;
    __device__ __forceinline__ const void* inptr(int i) const {
        const LAS unsigned* t = (const LAS unsigned*)(lds + PTR_OFF) + 2 * i;
        const unsigned lo = (unsigned)__builtin_amdgcn_readfirstlane((int)t[0]), hi = (unsigned)__builtin_amdgcn_readfirstlane((int)t[1]);
        return (const void*)(const GAS void*)(((unsigned long long)hi << 32) | lo);
    }
    __device__ __forceinline__ const float* x_prompt() const { return (const float*)inptr(0); }
    __device__ __forceinline__ const float* x_sample() const { return (const float*)inptr(1); }
    __device__ __forceinline__ const float* cache_nsa() const { return (const float*)inptr(2); }
    __device__ __forceinline__ const float* cache_win() const { return (const float*)inptr(3); }
    __device__ __forceinline__ const float* state_h() const { return (const float*)inptr(4); }
    __device__ __forceinline__ const float* state_conv() const { return (const float*)inptr(5); }
    __device__ __forceinline__ const int* page_table() const { return (const int*)inptr(6); }
    __device__ __forceinline__ const float* norm_a() const { return (const float*)inptr(7); }
    __device__ __forceinline__ const float* w_in_a() const { return (const float*)inptr(8); }
    __device__ __forceinline__ const float* b_gate_a() const { return (const float*)inptr(9); }
    __device__ __forceinline__ const float* pe_cmp() const { return (const float*)inptr(10); }
    __device__ __forceinline__ const float* w_cmp() const { return (const float*)inptr(11); }
    __device__ __forceinline__ const float* ln_g() const { return (const float*)inptr(12); }
    __device__ __forceinline__ const float* ln_b() const { return (const float*)inptr(13); }
    __device__ __forceinline__ const float* w_sp() const { return (const float*)inptr(14); }
    __device__ __forceinline__ const float* b_sp() const { return (const float*)inptr(15); }
    __device__ __forceinline__ const float* w_out_a() const { return (const float*)inptr(16); }
    __device__ __forceinline__ const float* norm_c() const { return (const float*)inptr(17); }
    __device__ __forceinline__ const float* w_in_c() const { return (const float*)inptr(18); }
    __device__ __forceinline__ const float* conv_w() const { return (const float*)inptr(19); }
    __device__ __forceinline__ const float* conv_b() const { return (const float*)inptr(20); }
    __device__ __forceinline__ const float* w_rg_a() const { return (const float*)inptr(21); }
    __device__ __forceinline__ const float* b_rg_a() const { return (const float*)inptr(22); }
    __device__ __forceinline__ const float* w_rg_x() const { return (const float*)inptr(23); }
    __device__ __forceinline__ const float* b_rg_x() const { return (const float*)inptr(24); }
    __device__ __forceinline__ const float* lam() const { return (const float*)inptr(25); }
    __device__ __forceinline__ const float* w_out_c() const { return (const float*)inptr(26); }
    __device__ __forceinline__ const float* rel_bias() const { return (const float*)inptr(27); }
    __device__ __forceinline__ const float* final_norm() const { return (const float*)inptr(28); }
};
__device__ __forceinline__ int lane_id() { int l_; asm volatile("v_mbcnt_lo_u32_b32 %0, -1, 0\n\tv_mbcnt_hi_u32_b32 %0, -1, %0" : "=v"(l_)); return l_; }
__device__ __forceinline__ void relaunder(Frame& F) { int t_ = F.wave * 64 + lane_id(); asm volatile("" : "+v"(t_)); F.tid = t_; F.lane = t_ & 63;
    unsigned long long w_ = (unsigned long long)F.ws, o_ = (unsigned long long)F.out; asm volatile("" : "+s"(w_), "+s"(o_)); F.ws = (unsigned char*)(GAS unsigned char*)w_; F.out = (float*)(GAS float*)o_; }
constexpr size_t O_YP = 0, O_YS = O_YP + (size_t)MP * D, O_NSAP = O_YS + (size_t)MS * D, O_NSAS = O_NSAP + (size_t)2 * MP * 512, O_WINP = O_NSAS + (size_t)2 * MS * 512,
                 O_WINS = O_WINP + (size_t)2 * BATCH * 512 * 256, O_GV = O_WINS + (size_t)2 * MS * 256, O_HP = O_GV + (size_t)2 * MS * 512, O_HS = O_HP + (size_t)2 * BATCH * 1024,
                 O_CVP = O_HS + (size_t)2 * DEC_B * 1024, O_CVS = O_CVP + (size_t)2 * BATCH * 3 * 1024, O_END = O_CVS + (size_t)2 * DEC_B * 3 * 1024;
__device__ __forceinline__ void tr_item(const float* W, int ldw, int src_col0, int nvalid, int K, bf16* WT, int dst_row0, int k0, LAS float* scr, int lane, const float* gain = nullptr) {
    const int c = lane & 31;
    float wv[32];
#pragma unroll
    for (int i = 0; i < 32; ++i) { const int kk = 2 * i + (lane >> 5); wv[i] = (c < nvalid) ? __builtin_nontemporal_load(W + (size_t)(k0 + kk) * ldw + src_col0 + c) : 0.f; }
#pragma unroll
    for (int i = 0; i < 32; ++i) { const int kk = 2 * i + (lane >> 5); scr[kk * 33 + c] = gain ? wv[i] * gain[k0 + kk] : wv[i]; }
    LDS_WAIT(); asm volatile("" ::: "memory");
    const int c8 = lane & 7;
#pragma unroll
    for (int j = 0; j < 4; ++j) { const int n = (lane >> 3) + 8 * j; const LAS float* s = scr + (8 * c8) * 33 + n;
        v4u o; o.x = pk2(s[0 * 33], s[1 * 33]); o.y = pk2(s[2 * 33], s[3 * 33]); o.z = pk2(s[4 * 33], s[5 * 33]); o.w = pk2(s[6 * 33], s[7 * 33]);
        *(GAS v4u*)(WT + (size_t)(dst_row0 + n) * K + k0 + 8 * c8) = o; }
    LDS_WAIT(); asm volatile("" ::: "memory");
}
constexpr int P0_I_INA = 16 * (NPA / 32), P0_I_OUT = 16 * 32, P0_I_INC = 16 * 64, P0_I_G = 8;
constexpr int P0_NITEMS = 2 * P0_I_INA + 2 * P0_I_OUT + 2 * P0_I_INC + 2 * P0_I_OUT + 2 * 8 * 2 * P0_I_G;
__device__ __forceinline__ void p0_weights(Frame& F, int it0, int it1, int gw, int NGW) {
    LAS float* scr = (LAS float*)(F.lds + RING_OFF + F.wave * 16384);
    constexpr int I_INA = P0_I_INA, I_OUT = P0_I_OUT, I_INC = P0_I_INC, I_G = P0_I_G;
    for (int it = it0 + gw; it < it1; it += NGW) {
        int r = it;
        if (r < 2 * I_INA) { const int a = r / I_INA; r %= I_INA; const int kb = r / (NPA / 32), nb = r % (NPA / 32), n0 = nb * 32;
            int src = n0, nv = 32; if (n0 == 1280) nv = 24; else if (n0 > 1280 && n0 < CZN) nv = 0; else if (n0 >= CZN) src = n0 - (CZN - 1304);
            tr_item(F.w_in_a() + (size_t)a * D * PROJ_A, PROJ_A, src, nv, D, (bf16*)(F.ws + WS_WINA) + (size_t)a * NPA * D, n0, kb * 64, scr, F.lane, F.norm_a() + a * D); continue; }
        r -= 2 * I_INA;
        if (r < 2 * I_OUT) { const int a = r / I_OUT; r %= I_OUT; const int kb = r / 32, nb = r % 32;
            tr_item(F.w_out_a() + (size_t)a * D * D, D, nb * 32, 32, D, (bf16*)(F.ws + WS_WOUTA) + (size_t)a * D * D, nb * 32, kb * 64, scr, F.lane); continue; }
        r -= 2 * I_OUT;
        if (r < 2 * I_INC) { const int c = r / I_INC; r %= I_INC; const int kb = r / 64, nb = r % 64;
            tr_item(F.w_in_c() + (size_t)c * D * 2048, 2048, nb * 32, 32, D, (bf16*)(F.ws + WS_WINC) + (size_t)c * 2048 * D, nb * 32, kb * 64, scr, F.lane, F.norm_c() + c * D); continue; }
        r -= 2 * I_INC;
        if (r < 2 * I_OUT) { const int c = r / I_OUT; r %= I_OUT; const int kb = r / 32, nb = r % 32;
            tr_item(F.w_out_c() + (size_t)c * D * D, D, nb * 32, 32, D, (bf16*)(F.ws + WS_WOUTC) + (size_t)c * D * D, nb * 32, kb * 64, scr, F.lane); continue; }
        r -= 2 * I_OUT;
        {
            const int ch = r / (2 * I_G); r %= (2 * I_G); const int which = r / I_G; r %= I_G; const int kb = r / 4, nb = r % 4;
            const float* W = (which ? F.w_rg_x() : F.w_rg_a()) + (size_t)ch * 128 * 128;
            tr_item(W, 128, nb * 32, 32, 128, (bf16*)(F.ws + WS_WG) + (size_t)ch * 256 * 128, which * 128 + nb * 32, kb * 64, scr, F.lane); }
    }
}
__device__ __forceinline__ void p0_tril(Frame& F, int gt, int NT) {
    if (gt < 256) { const int a = gt >> 7, kv = (gt >> 6) & 1, dd = gt & 63; const float* pe = F.pe_cmp() + (size_t)a * 2 * 4096 + kv * 4096 + dd; float sm = 0.f;
#pragma unroll 16
        for (int c = 0; c < 64; ++c) sm += pe[c * 64];
        ((float*)(F.ws + WS_PEM))[gt] = sm * (1.0f / 64.0f); }
    bf16* wsp = (bf16*)(F.ws + WS_WSP);
    for (int e = gt; e < 2 * 4 * 128 * 128; e += NT) { const int j = e & 127, i = (e >> 7) & 127; wsp[e] = (bf16)((j <= i) ? f2bf(F.w_sp()[e]) : 0u); }
}
__device__ __forceinline__ void p0_late(Frame& F, int idx, int n) {
    p0_weights(F, P0_I_INA, P0_NITEMS, idx * NWAVES + F.wave, n * NWAVES);
    p0_tril(F, idx * (NWAVES * 64) + F.tid, n * NWAVES * 64);
}
__device__ __forceinline__ void p0_prologue(Frame& F, bool all) {
    const int gw = F.vcu * NWAVES + F.wave, NGW = F.G * NWAVES;
    p0_weights(F, 0, all ? P0_NITEMS : P0_I_INA, gw, NGW);
    if (all) p0_tril(F, F.vcu * (NWAVES * 64) + F.tid, F.G * NWAVES * 64);
    bf16* XG = (bf16*)(F.ws + WS_XG); float* SSQ = (float*)(F.ws + WS_SSQ);
    for (int m0 = gw; m0 < M; m0 += 4 * NGW) {
        f32x4 v[4][4];
#pragma unroll
        for (int q = 0; q < 4; ++q) { const int m = m0 + q * NGW; if (m < M) { const float* xrow = (m < MP) ? F.x_prompt() + (size_t)m * D : F.x_sample() + (size_t)(m - MP) * D; const GAS f32x4* xr = (const GAS f32x4*)xrow + F.lane;
#pragma unroll
                for (int j = 0; j < 4; ++j) v[q][j] = __builtin_nontemporal_load(xr + 64 * j); } }
#pragma unroll
        for (int q = 0; q < 4; ++q) { const int m = m0 + q * NGW; if (m < M) {
            float s = 0.f; GAS v2u* o8 = (GAS v2u*)(XG + (size_t)m * D) + F.lane;
#pragma unroll
            for (int j = 0; j < 4; ++j) { const f32x4 x = v[q][j]; s += (x.x * x.x + x.y * x.y) + (x.z * x.z + x.w * x.w);
                v2u w; w.x = pk2(x.x, x.y); w.y = pk2(x.z, x.w); o8[64 * j] = w; }
            s = wave_sum(s);
            if (F.lane < 16) SSQ[(size_t)m * 16 + F.lane] = (F.lane == 0) ? s : 0.f; } }
    }
}
__device__ __forceinline__ void p_final(Frame& F) {
    const int gw = F.vcu * NWAVES + F.wave, NGW = F.G * NWAVES;
    const bf16* R = (const bf16*)(F.ws + WS_XG); const float* SSQ = (const float*)(F.ws + WS_SSQ);
    const GAS f32x4* gr = (const GAS f32x4*)F.final_norm() + F.lane; f32x4 g[4];
#pragma unroll
    for (int j = 0; j < 4; ++j) g[j] = gr[64 * j];
    for (int m0 = gw; m0 < M; m0 += 4 * NGW) {
        v2u v[4][4]; float ri[4];
#pragma unroll
        for (int q = 0; q < 4; ++q) { const int m = m0 + q * NGW; if (m < M) { const GAS v2u* yr = (const GAS v2u*)(R + (size_t)m * D) + F.lane;
#pragma unroll
                for (int j = 0; j < 4; ++j) v[q][j] = __builtin_nontemporal_load(yr + 64 * j);
                ri[q] = pg8::row_rinv(SSQ, m); } }
#pragma unroll
        for (int q = 0; q < 4; ++q) { const int m = m0 + q * NGW; if (m < M) {
            GAS f32x4* o = (GAS f32x4*)(F.out + ((m < MP) ? O_YP + (size_t)m * D : O_YS + (size_t)(m - MP) * D)) + F.lane;
#pragma unroll
            for (int j = 0; j < 4; ++j) { const f32x4 y = {bflo(v[q][j].x), bfhi(v[q][j].x), bflo(v[q][j].y), bfhi(v[q][j].y)}; __builtin_nontemporal_store(y * ri[q] * g[j], o + 64 * j); } } }
    }
}
__device__ __forceinline__ int vkey(int ks2, int kq, int e) { return (2 * ks2 + (e >> 2)) * 16 + kq * 4 + (e & 3); }

constexpr int PREP_W = 8 * 9216, PREP_PE = PREP_W + 2 * 4096 * 4, PREP_VEC = PREP_PE + 2 * 64 * 4;
template <class DP>
__device__ __forceinline__ void cmp_matvec_store(Frame& F, int kv, const LAS float* vec, DP dstK, DP dstV, int blk, int nks2, int woff = PREP_W) {
    const LAS float* Wl = (const LAS float*)(F.lds + RING_OFF + woff) + kv * 4096 + F.lane; float o0 = 0.f, o1 = 0.f;
#pragma unroll 8
    for (int d = 0; d < 64; d += 4) { const f32x4 v4 = *(const LAS f32x4*)(vec + d);
        o0 += v4[0] * Wl[d * 64]; o1 += v4[1] * Wl[d * 64 + 64]; o0 += v4[2] * Wl[d * 64 + 128]; o1 += v4[3] * Wl[d * 64 + 192]; }
    const int e = F.lane; const bf16 ob = (bf16)f2bf(o0 + o1);
    if (kv == 0) { const int Tt = blk >> 4, r16 = blk & 15, ks = e >> 5, kq = (e & 31) >> 3, j = e & 7; dstK[((size_t)(Tt * 2 + ks) * 64 + r16 + 16 * kq) * 8 + j] = ob; }
    else { const int grp = blk >> 6, kb = blk & 63, t16 = kb >> 4, r = kb & 15, ks2 = t16 >> 1, ee = (t16 & 1) * 4 + (r & 3), kq = r >> 2, dt = e >> 4;
        dstV[((size_t)((grp * 4 + dt) * nks2 + ks2) * 64 + (e & 15) + 16 * kq) * 8 + ee] = ob; }
}

__device__ __forceinline__ void p_prep(Frame& F, int a) {
    const bf16* PROJ = (const bf16*)(F.ws + WS_PROJ);
    constexpr int NP = BATCH * 128, NSI = 0;
    {
        LAS float* Wl = (LAS float*)(F.lds + RING_OFF + PREP_W); LAS float* pem = (LAS float*)(F.lds + RING_OFF + PREP_PE);
        const float* wc = F.w_cmp() + (size_t)a * 2 * 4096;
        for (int e = F.tid; e < 2 * 4096; e += NWAVES * 64) Wl[e] = wc[e];
        if (F.tid < 128) pem[F.tid] = ((const float*)(F.ws + WS_PEM))[a * 128 + F.tid];
        LDS_WAIT(); __syncthreads();
    }
    const LAS float* pem = (const LAS float*)(F.lds + RING_OFF + PREP_PE);
    for (int it = F.vcu; it < NP + NSI; it += F.G) {
        relaunder(F);
        const int w = F.wave; LAS float* vec = (LAS float*)(F.lds + RING_OFF + PREP_VEC) + w * 64;
        {
            const int b = it >> 7, blk = it & 127;
            if (w < 4) {
                const int kv = w & 1, g = w >> 1;
                vec[F.lane] = ((const float*)(F.ws + WS_MEAN))[(((size_t)(b * 128 + blk) * 2 + kv) * 2 + g) * 64 + F.lane] + pem[kv * 64 + F.lane];
                LDS_WAIT(); asm volatile("" ::: "memory");
                cmp_matvec_store(F, kv, vec, (bf16*)(F.ws + WS_KCF) + (size_t)(b * 2 + g) * 8192, (bf16*)(F.ws + WS_VCF) + (size_t)(b * 2 + g) * 8192, blk, 2);
                LDS_WAIT(); asm volatile("" ::: "memory");
            }
        }
    }
}
constexpr int ATT_LUT = 0, ATT_LUTN = 1168, ATT_SCORE = 18944, ATT_SELM = ATT_SCORE + 16384, ATT_RING = 36864, ATT_NS = 6, ATT_SLOT = 16384, ATT_QF = ATT_RING + ATT_NS * ATT_SLOT  , ATT_VCF = ATT_RING + 4 * ATT_SLOT, ATT_MERGE = ATT_RING, ATT_FLAGS = ATT_RING - 64;
static_assert(ATT_SELM + 1024 <= ATT_RING && ATT_QF + 8 * 2048 <= SCRATCH_BYTES && ATT_MERGE + 8 * 2 * 18 * 64 * 4 <= SCRATCH_BYTES, "attention LDS map");
#define XROW_SWAP(op_, a_, b_) asm volatile("s_nop 1\n\t" op_ " %0, %1" : "+v"(a_), "+v"(b_))
__device__ __forceinline__ float xrow16_max(float x) { float a = x, b = x; XROW_SWAP("v_permlane16_swap_b32", a, b); x = fmaxf(a, b); a = x; b = x; XROW_SWAP("v_permlane32_swap_b32", a, b); return fmaxf(a, b); }
__device__ __forceinline__ float xrow16_sum(float x) { float a = x, b = x; XROW_SWAP("v_permlane16_swap_b32", a, b); x = a + b; a = x; b = x; XROW_SWAP("v_permlane32_swap_b32", a, b); return a + b; }
template <int CTRL> __device__ __forceinline__ float dpp_q(float x) { return __builtin_bit_cast(float, __builtin_amdgcn_mov_dpp(__builtin_bit_cast(int, x), CTRL, 0xf, 0xf, true)); }
struct QState { float m, l; f32x4 o[4]; };
__device__ __forceinline__ void qs_init(QState& s) { s.m = -1e30f; s.l = 0.f;
#pragma unroll
    for (int i = 0; i < 4; ++i) s.o[i] = (f32x4){0.f, 0.f, 0.f, 0.f}; }

template <int MODE>
__device__ __forceinline__ void quad_qk(QState& st, bf16x8 (&pb)[2], const bf16x8 (&qf)[2], const bf16x8 (&kf)[8], int qpos, int kbase, bool colsel, const LAS float* lut, int kq) {
    f32x4 s[4];
#pragma unroll
    for (int kt = 0; kt < 4; ++kt) { s[kt] = (f32x4){0.f, 0.f, 0.f, 0.f}; s[kt] = mfma16(kf[kt * 2], qf[0], s[kt]); s[kt] = mfma16(kf[kt * 2 + 1], qf[1], s[kt]); }
    float mx = -1e30f;
#pragma unroll
    for (int kt = 0; kt < 4; ++kt)
#pragma unroll
        for (int i = 0; i < 4; ++i) {
            const int d = qpos - (kbase + kt * 16 + kq * 4 + i);
            const bool v = colsel && d >= 0 && (MODE == 0 || d <= 512);
            const int dd = d < 0 ? 0 : (d > 1023 ? 1023 : d);
            const float lb = lut[1023 - dd]; const float xv = v ? s[kt][i] * SCL + lb : -1e30f;
            s[kt][i] = xv; mx = fmaxf(mx, xv);
        }
    mx = xrow16_max(mx);
    const float mn = fmaxf(st.m, mx), alpha = fexp2(st.m - mn);
    float ls = 0.f;
#pragma unroll
    for (int kt = 0; kt < 4; ++kt)
#pragma unroll
        for (int i = 0; i < 4; ++i) { const float p = (s[kt][i] > -1e29f) ? fexp2(s[kt][i] - mn) : 0.f; s[kt][i] = p; ls += p; }
    st.l = st.l * alpha + ls; st.m = mn;
#pragma unroll
    for (int dt = 0; dt < 4; ++dt) st.o[dt] *= alpha;
    pb[0] = pack8(s[0], s[1]); pb[1] = pack8(s[2], s[3]);
}
__device__ __forceinline__ void quad_pv(QState& st, const bf16x8 (&pb)[2], const bf16x8 (&vf)[8]) {
#pragma unroll
    for (int dt = 0; dt < 4; ++dt) { st.o[dt] = mfma16(vf[dt * 2], pb[0], st.o[dt]); st.o[dt] = mfma16(vf[dt * 2 + 1], pb[1], st.o[dt]); }
}
__device__ __forceinline__ void qs_finish(QState& st) {
    const float l = xrow16_sum(st.l);
    const float inv = l > 0.f ? 1.0f / l : 0.f;
#pragma unroll
    for (int dt = 0; dt < 4; ++dt) st.o[dt] *= inv;
}

template <int NKT_MAX, int NKS2G, class KP, class VP>
__device__ __forceinline__ void quad_cmp(f32x4 (&o)[4], const bf16x8 (&qf)[2], KP kcf, VP vcf, int nkt, int qpos, const LAS float* lut, LAS float* score  , int lane) {
    const int kq = lane >> 4, c = lane & 15;
    f32x4 s[NKT_MAX]; float mx = -1e30f;
#pragma unroll
    for (int Tt = 0; Tt < NKT_MAX; ++Tt) {
        s[Tt] = (f32x4){0.f, 0.f, 0.f, 0.f};
        if (Tt < nkt) { s[Tt] = mfma16(kcf[(Tt * 2) * 64 + lane], qf[0], s[Tt]); s[Tt] = mfma16(kcf[(Tt * 2 + 1) * 64 + lane], qf[1], s[Tt]); }
#pragma unroll
        for (int i = 0; i < 4; ++i) {
            const int blk = Tt * 16 + kq * 4 + i, d = qpos - (blk * 64 + 63);
            const bool v = (Tt < nkt) && d >= 0; const int dd = d < 0 ? 0 : (d > 1023 ? 1023 : d);
            const float lb = lut[1023 - dd]; const float xv = v ? s[Tt][i] * SCL + lb : -1e30f; s[Tt][i] = xv; mx = fmaxf(mx, xv);
        }
    }
    mx = xrow16_max(mx);
    float ls = 0.f;
#pragma unroll
    for (int Tt = 0; Tt < NKT_MAX; ++Tt)
#pragma unroll
        for (int i = 0; i < 4; ++i) { const float p = (s[Tt][i] > -1e29f) ? fexp2(s[Tt][i] - mx) : 0.f; s[Tt][i] = p; ls += p; }
    ls = xrow16_sum(ls);
    const float inv = ls > 0.f ? 1.0f / ls : 0.f;
#pragma unroll
    for (int Tt = 0; Tt < NKT_MAX; ++Tt)
#pragma unroll
        for (int i = 0; i < 4; ++i) {
            const float p = s[Tt][i] * inv; s[Tt][i] = p;
            float sc = p + dpp_q<0xB1>(p); sc += dpp_q<0x4E>(sc);
            if ((c & 3) == 0 && Tt < nkt) score[(c >> 2) * 128 + Tt * 16 + kq * 4 + i] = sc;
        }
#pragma unroll
    for (int dt = 0; dt < 4; ++dt) o[dt] = (f32x4){0.f, 0.f, 0.f, 0.f};
#pragma unroll
    for (int KS = 0; KS < NKT_MAX / 2; ++KS) {
        if (2 * KS < nkt) {
            const bf16x8 pb = pack8(s[2 * KS], s[2 * KS + 1]);
            const int grp = (NKS2G == 2) ? (KS >> 1) : 0, ks2 = (NKS2G == 2) ? (KS & 1) : 0;
#pragma unroll
            for (int dt = 0; dt < 4; ++dt) o[dt] = mfma16(vcf[((grp * 4 + dt) * NKS2G + ks2) * 64 + lane], pb, o[dt]);
        }
    }
}

__device__ __forceinline__ void select_blocks(const LAS float* score, int cur, int lane, unsigned long long& m0, unsigned long long& m1) {
    const int nc = cur - 2;
    unsigned long long f0 = 1ull, f1 = 0ull;
    { const int a = cur, b = cur - 1; if (a < 64) f0 |= 1ull << a; else f1 |= 1ull << (a - 64); if (b >= 0) { if (b < 64) f0 |= 1ull << b; else f1 |= 1ull << (b - 64); } }
    if (nc <= 13) {
        m0 = (cur >= 63) ? ~0ull : ((1ull << (cur + 1)) - 1ull); m1 = (cur < 64) ? 0ull : ((cur - 64 >= 63) ? ~0ull : ((1ull << (cur - 64 + 1)) - 1ull));
        return; }
    const int j0 = lane, j1 = lane + 64;
    const bool v0 = (j0 >= 1 && j0 <= cur - 2), v1 = (j1 <= cur - 2);
    const unsigned k0 = v0 ? (__builtin_bit_cast(unsigned, score[j0]) + 1u) : 0u, k1 = v1 ? (__builtin_bit_cast(unsigned, score[j1]) + 1u) : 0u;
    unsigned t = 0u;
    for (int bit = 30; bit >= 0; --bit) {
        const unsigned cand = t | (1u << bit);
        const int cnt = __popcll(__ballot(k0 >= cand)) + __popcll(__ballot(k1 >= cand));
        if (cnt >= 13) t = cand;
    }
    const bool g0 = k0 > t, g1 = k1 > t, e0 = (k0 == t), e1 = (k1 == t);
    const unsigned long long bg0 = __ballot(g0), bg1 = __ballot(g1), be0 = __ballot(e0), be1 = __ballot(e1);
    const int need = 13 - (__popcll(bg0) + __popcll(bg1));
    const unsigned long long lt = (lane == 0) ? 0ull : (~0ull >> (64 - lane));
    const int r0 = __popcll(be0 & lt), r1 = __popcll(be0) + __popcll(be1 & lt);
    const bool s0 = g0 || (e0 && r0 < need), s1 = g1 || (e1 && r1 < need);
    m0 = __ballot(s0) | f0; m1 = __ballot(s1) | f1;
}
__device__ __forceinline__ void load_frags8(bf16x8 (&f)[8], const bf16x8* base, int lane) {
#pragma unroll
    for (int i = 0; i < 8; ++i) f[i] = base[i * 64 + lane];
}
__device__ __forceinline__ void build_lut(Frame& F, int g) {
    LAS float* lut = (LAS float*)(F.lds + RING_OFF + ATT_LUT); const float* rb = F.rel_bias();
    for (int e = F.tid; e < 4 * ATT_LUTN; e += NWAVES * 64) { const int h = e / ATT_LUTN, idx = e - h * ATT_LUTN, d = 1023 - idx; lut[e] = d >= 0 ? rb[rel_bucket(d) * 8 + 4 * g + h] * LOG2E : 0.f; }
}
template <int BIAS, int MASK>
__device__ __forceinline__ void quad_qk2(QState& st, bf16x8 (&pb)[2], const bf16x8 (&qf)[2], const bf16x8 (&kf)[8], float cinit, const LAS float* lutp, int dk) {
    f32x4 s[4];
#pragma unroll
    for (int kt = 0; kt < 4; ++kt) { s[kt] = (f32x4){cinit, cinit, cinit, cinit}; s[kt] = mfma16(kf[kt * 2], qf[0], s[kt]); s[kt] = mfma16(kf[kt * 2 + 1], qf[1], s[kt]); }
    float mx;
    if (BIAS == 0 && MASK == 0) {
        const float m0 = fmaxf(fmaxf(s[0][0], s[0][1]), fmaxf(s[0][2], s[0][3])), m1 = fmaxf(fmaxf(s[1][0], s[1][1]), fmaxf(s[1][2], s[1][3]));
        const float m2 = fmaxf(fmaxf(s[2][0], s[2][1]), fmaxf(s[2][2], s[2][3])), m3 = fmaxf(fmaxf(s[3][0], s[3][1]), fmaxf(s[3][2], s[3][3]));
        mx = fmaxf(fmaxf(m0, m1), fmaxf(m2, m3)) * SCL;
    } else {
        mx = -1e30f;
#pragma unroll
        for (int kt = 0; kt < 4; ++kt)
#pragma unroll
            for (int i = 0; i < 4; ++i) {
                float x = s[kt][i] * SCL + (BIAS ? lutp[kt * 16 + i] : 0.f);
                if (MASK == 1) x = (dk - (kt * 16 + i) >= 0) ? x : -1e30f;
                if (MASK == 2) x = (dk - (kt * 16 + i) <= 512) ? x : -1e30f;
                s[kt][i] = x; mx = fmaxf(mx, x);
            }
    }
    mx = xrow16_max(mx);
    if (__any(mx > st.m)) {
        const float mn = fmaxf(st.m, mx), alpha = fexp2(st.m - mn); st.l *= alpha; st.m = mn;
#pragma unroll
        for (int dt = 0; dt < 4; ++dt) st.o[dt] *= alpha;
    }
    const float mn = st.m; float ls = 0.f;
#pragma unroll
    for (int kt = 0; kt < 4; ++kt)
#pragma unroll
        for (int i = 0; i < 4; ++i) { const float p = (BIAS == 0 && MASK == 0) ? fexp2(s[kt][i] * SCL - mn) : fexp2(s[kt][i] - mn); s[kt][i] = p; ls += p; }
    st.l += ls;
    pb[0] = pack8(s[0], s[1]); pb[1] = pack8(s[2], s[3]);
}
constexpr float ATT_THR = 8.0f;
#ifndef PROBE_RING
#define PROBE_RING 0
#endif
template <int BIAS, int MASK, bool A0, bool A1>
__device__ __forceinline__ void qk_pair(QState (&st)[2], bf16x8 (&pb)[2][2], const bf16x8 (&qf)[2][2], const bf16x8 (&kf)[8], float c0, float c1, const LAS float* lp0, const LAS float* lp1, int dk0, int dk1) {
    f32x4 s[2][4]; float mx[2], mb[2];
#pragma unroll
    for (int qd = 0; qd < 2; ++qd) { if (!(qd ? A1 : A0)) continue;
        mb[qd] = (BIAS == 0 && MASK == 0) ? (st[qd].m > -1e29f ? st[qd].m : 0.f) : 0.f;
        const float ci = (qd ? c1 : c0) - mb[qd];
#pragma unroll
        for (int kt = 0; kt < 4; ++kt) { s[qd][kt] = (f32x4){ci, ci, ci, ci}; s[qd][kt] = mfma16(kf[kt * 2], qf[qd][0], s[qd][kt]); s[qd][kt] = mfma16(kf[kt * 2 + 1], qf[qd][1], s[qd][kt]); } }
    if (BIAS == 0 && MASK == 0) {
        bool trig = false;
#pragma unroll
        for (int qd = 0; qd < 2; ++qd) { if (!(qd ? A1 : A0)) { mx[qd] = -3e38f; continue; }
            const float m0 = fmaxf(fmaxf(s[qd][0][0], s[qd][0][1]), fmaxf(s[qd][0][2], s[qd][0][3])), m1 = fmaxf(fmaxf(s[qd][1][0], s[qd][1][1]), fmaxf(s[qd][1][2], s[qd][1][3]));
            const float m2 = fmaxf(fmaxf(s[qd][2][0], s[qd][2][1]), fmaxf(s[qd][2][2], s[qd][2][3])), m3 = fmaxf(fmaxf(s[qd][3][0], s[qd][3][1]), fmaxf(s[qd][3][2], s[qd][3][3]));
            mx[qd] = fmaxf(fmaxf(m0, m1), fmaxf(m2, m3));
            trig = trig || (mx[qd] > ATT_THR) || (st[qd].m < -1e29f && mx[qd] > -1e29f); }
        if (__any(trig)) {
#pragma unroll
            for (int qd = 0; qd < 2; ++qd) { if (!(qd ? A1 : A0)) continue;
                const float mc = xrow16_max(mx[qd]), mabs = mc > -1e29f ? mb[qd] + mc : -1e30f;
                const float mn = fmaxf(st[qd].m, mabs), alpha = fexp2(st[qd].m - mn), sh = mn - mb[qd];
                st[qd].l *= alpha; st[qd].m = mn;
#pragma unroll
                for (int dt = 0; dt < 4; ++dt) st[qd].o[dt] *= alpha;
#pragma unroll
                for (int kt = 0; kt < 4; ++kt) s[qd][kt] -= sh; }
        }
#pragma unroll
        for (int qd = 0; qd < 2; ++qd) { if (!(qd ? A1 : A0)) continue;
            float ls = 0.f;
#pragma unroll
            for (int kt = 0; kt < 4; ++kt)
#pragma unroll
                for (int i = 0; i < 4; ++i) { const float p = fexp2(s[qd][kt][i]); s[qd][kt][i] = p; ls += p; }
            st[qd].l += ls;
            pb[qd][0] = pack8(s[qd][0], s[qd][1]); pb[qd][1] = pack8(s[qd][2], s[qd][3]); }
        return;
    }
#pragma unroll
    for (int qd = 0; qd < 2; ++qd) { if (!(qd ? A1 : A0)) { mx[qd] = -3e38f; continue; }
        const int dk = qd ? dk1 : dk0; const LAS float* lp = qd ? lp1 : lp0;
        float m = -1e30f;
#pragma unroll
        for (int kt = 0; kt < 4; ++kt)
#pragma unroll
            for (int i = 0; i < 4; ++i) {
                float x = s[qd][kt][i] + (BIAS ? lp[kt * 16 + i] : 0.f);
                if (MASK == 1) x = (dk - (kt * 16 + i) >= 0) ? x : -1e30f;
                if (MASK == 2) x = (dk - (kt * 16 + i) <= 512) ? x : -1e30f;
                s[qd][kt][i] = x; m = fmaxf(m, x);
            }
        mx[qd] = xrow16_max(m);
    }
    if (__any((A0 && mx[0] > st[0].m) || (A1 && mx[1] > st[1].m))) {
#pragma unroll
        for (int qd = 0; qd < 2; ++qd) { if (!(qd ? A1 : A0)) continue;
            const float mn = fmaxf(st[qd].m, mx[qd]), alpha = fexp2(st[qd].m - mn); st[qd].l *= alpha; st[qd].m = mn;
#pragma unroll
            for (int dt = 0; dt < 4; ++dt) st[qd].o[dt] *= alpha; }
    }
#pragma unroll
    for (int qd = 0; qd < 2; ++qd) { if (!(qd ? A1 : A0)) continue;
        const float mn = st[qd].m; float ls = 0.f;
#pragma unroll
        for (int kt = 0; kt < 4; ++kt)
#pragma unroll
            for (int i = 0; i < 4; ++i) { const float p = fexp2(s[qd][kt][i] - mn); s[qd][kt][i] = p; ls += p; }
        st[qd].l += ls;
        pb[qd][0] = pack8(s[qd][0], s[qd][1]); pb[qd][1] = pack8(s[qd][2], s[qd][3]); }
}
template <bool A0, bool A1>
__device__ __forceinline__ void pv_pair(QState (&st)[2], const bf16x8 (&pb)[2][2], const bf16x8 (&vf)[8]) {
#pragma unroll
    for (int dt = 0; dt < 4; ++dt) {
        if (A0) { st[0].o[dt] = mfma16(vf[dt * 2], pb[0][0], st[0].o[dt]); st[0].o[dt] = mfma16(vf[dt * 2 + 1], pb[0][1], st[0].o[dt]); }
        if (A1) { st[1].o[dt] = mfma16(vf[dt * 2], pb[1][0], st[1].o[dt]); st[1].o[dt] = mfma16(vf[dt * 2 + 1], pb[1][1], st[1].o[dt]); } }
}
__device__ __forceinline__ void nsa_store(Frame& F, int a, int row, int head, const f32x4 (&oc)[4], const f32x4 (&os)[4], const f32x4 (&ow)[4], int kq) {
    const bf16* PROJ = (const bf16*)(F.ws + WS_PROJ); bf16* YCAT = (bf16*)(F.ws + WS_ACT2);
    const bf16* pr = PROJ + (size_t)row * NPA; const float* bg = F.b_gate_a() + a * 24;
    const float g0 = fsigmoid(bf2f(pr[CGATE + head]) + bg[head]), g1 = fsigmoid(bf2f(pr[CGATE + 8 + head]) + bg[8 + head]), g2 = fsigmoid(bf2f(pr[CGATE + 16 + head]) + bg[16 + head]);
#pragma unroll
    for (int dt = 0; dt < 4; ++dt) {
        const int dim = dt * 16 + kq * 4; const v2u z = *(const v2u*)(pr + CZN + head * 64 + dim);
        const f32x4 o = oc[dt] * g0 + os[dt] * g1 + ow[dt] * g2;
        v2u w; w.x = pk2(o[0] * fsilu(bflo(z.x)), o[1] * fsilu(bfhi(z.x))); w.y = pk2(o[2] * fsilu(bflo(z.y)), o[3] * fsilu(bfhi(z.y)));
        *(v2u*)(YCAT + (size_t)row * D + head * 64 + dim) = w;
    }
}

__device__ __forceinline__ void att_issue(const bf16x8* kb, const bf16x8* vb, int j, LAS unsigned char* slot, int w, int lane) {
    const GAS unsigned char* base = (const GAS unsigned char*)((w < 4) ? kb : vb) + ((size_t)j * 512 + (size_t)((2 * w) & 7) * 64) * 16;
    unsigned voff = (unsigned)lane * 16u; asm volatile("" : "+v"(voff));
    LAS unsigned char* dst = slot + (2 * w) * 1024;
    __builtin_amdgcn_global_load_lds((const GAS unsigned*)(base + voff), (LAS unsigned*)dst, 16, 0, 0);
    __builtin_amdgcn_global_load_lds((const GAS unsigned*)(base + 1024 + voff), (LAS unsigned*)(dst + 1024), 16, 0, 0);
}
__device__ __forceinline__ void attn_prompt_unit(Frame& F, int a, int b, int g, int qt) {
    const bf16* PROJ = (const bf16*)(F.ws + WS_PROJ);
    const int lane = F.lane, w = F.wave, kq = lane >> 4, c = lane & 15, ql = c >> 2, h = c & 3, cur = qt, t0 = qt * 64;
    const LAS float* lut = (const LAS float*)(F.lds + RING_OFF + ATT_LUT) + h * ATT_LUTN;
    LAS float* score = (LAS float*)(F.lds + RING_OFF + ATT_SCORE) + w * 512;
    LAS unsigned long long* selm = (LAS unsigned long long*)(F.lds + RING_OFF + ATT_SELM) + w * 16;
    LAS unsigned char* ring = F.lds + RING_OFF + ATT_RING;
    const size_t bg = (size_t)(b * 2 + g);
    const bf16x8* KS = (const bf16x8*)(F.ws + WS_KSLC) + bg * 128 * 512; const bf16x8* VS = (const bf16x8*)(F.ws + WS_VSLC) + bg * 128 * 512;
    const bf16x8* KW = (const bf16x8*)(F.ws + WS_KWIN) + bg * 128 * 512; const bf16x8* VW = (const bf16x8*)(F.ws + WS_VWIN) + bg * 128 * 512;
    const int jw0 = cur - 8 < 0 ? 0 : cur - 8, nw = cur - jw0 + 1, n = nw + cur + 1;
#define ATT_ISSUE(it) do { const int it_ = (it); if (it_ < nw) att_issue(KW, VW, jw0 + it_, ring + (it_ % ATT_NS) * ATT_SLOT, w, lane); else att_issue(KS, VS, it_ - nw, ring + (it_ % ATT_NS) * ATT_SLOT, w, lane); } while (0)
    { const bf16x8* ksrc = (const bf16x8*)(F.ws + WS_KCF) + bg * 1024 + (size_t)(2 * w) * 64 + lane; const bf16x8* vsrc = (const bf16x8*)(F.ws + WS_VCF) + bg * 1024 + (size_t)(2 * w) * 64 + lane;
      LAS unsigned char* kd = ring + 3 * ATT_SLOT + (2 * w) * 1024; LAS unsigned char* vd = F.lds + RING_OFF + ATT_VCF + (2 * w) * 1024;
      __builtin_amdgcn_global_load_lds((const unsigned*)ksrc, (LAS unsigned*)kd, 16, 0, 0); __builtin_amdgcn_global_load_lds((const unsigned*)(ksrc + 64), (LAS unsigned*)(kd + 1024), 16, 0, 0);
      __builtin_amdgcn_global_load_lds((const unsigned*)vsrc, (LAS unsigned*)vd, 16, 0, 0); __builtin_amdgcn_global_load_lds((const unsigned*)(vsrc + 64), (LAS unsigned*)(vd + 1024), 16, 0, 0); }
    ATT_ISSUE(0); if (n > 1) ATT_ISSUE(1); if (n > 2) ATT_ISSUE(2);
    unsigned* prel = (unsigned*)(F.ws + WS_ATTPRE) + ((size_t)blockIdx.x * 8 + w) * 1280 + 4 * 64 + lane;
    const int nkt = 2 * (cur / 32 + 1);
    bf16x8 qf[2][2]; f32x4 pre[2][4]; int qpos[2]; unsigned long long u0[2], u1[2]; float gt0[2], gt1[2], gt2[2];
    { unsigned short gl[2][3]; float gb[3];
#pragma unroll
      for (int qd = 0; qd < 2; ++qd) { qpos[qd] = t0 + w * 8 + qd * 4 + ql; const bf16* pr = PROJ + (size_t)(b * T + qpos[qd]) * NPA;
#pragma unroll
          for (int ks = 0; ks < 2; ++ks) qf[qd][ks] = *(const bf16x8*)(pr + CQ + (4 * g + h) * 64 + ks * 32 + kq * 8);
#pragma unroll
          for (int br = 0; br < 3; ++br) gl[qd][br] = pr[CGATE + 8 * br + 4 * g + h]; }
      const float* bgp = F.b_gate_a() + a * 24 + 4 * g + h;
#pragma unroll
      for (int br = 0; br < 3; ++br) gb[br] = bgp[8 * br];
#pragma unroll
      for (int qd = 0; qd < 2; ++qd) { gt0[qd] = fsigmoid(bf2f(gl[qd][0]) + gb[0]); gt1[qd] = fsigmoid(bf2f(gl[qd][1]) + gb[1]); gt2[qd] = fsigmoid(bf2f(gl[qd][2]) + gb[2]);
          prel[(qd - 4) * 64] = __builtin_bit_cast(unsigned, gt1[qd]); prel[(qd - 2) * 64] = __builtin_bit_cast(unsigned, gt2[qd]); } }
    asm volatile("s_waitcnt vmcnt(0)" ::: "memory"); LDS_BARRIER();
#pragma unroll
    for (int qd = 0; qd < 2; ++qd) {
        quad_cmp<8, 2>(pre[qd], qf[qd], (const LAS bf16x8*)(ring + 3 * ATT_SLOT), (const LAS bf16x8*)(F.lds + RING_OFF + ATT_VCF), nkt, qpos[qd], lut, score, lane);
        LDS_WAIT(); asm volatile("" ::: "memory");
        unsigned long long uu0 = 0ull, uu1 = 0ull, mm0 = 0ull, mm1 = 0ull;
        for (int q = 0; q < 4; ++q) { unsigned long long m0, m1; select_blocks(score + q * 128, cur, lane, m0, m1); uu0 |= m0; uu1 |= m1; if (q == ql) { mm0 = m0; mm1 = m1; } }
        selm[(qd * 4 + ql) * 2] = mm0; selm[(qd * 4 + ql) * 2 + 1] = mm1;
        u0[qd] = ((unsigned long long)(unsigned)__builtin_amdgcn_readfirstlane((int)(unsigned)(uu0 >> 32)) << 32) | (unsigned)__builtin_amdgcn_readfirstlane((int)(unsigned)uu0);
        u1[qd] = ((unsigned long long)(unsigned)__builtin_amdgcn_readfirstlane((int)(unsigned)(uu1 >> 32)) << 32) | (unsigned)__builtin_amdgcn_readfirstlane((int)(unsigned)uu1);
        LDS_WAIT(); asm volatile("" ::: "memory");
#pragma unroll
        for (int dt = 0; dt < 4; ++dt) { const f32x4 pv = pre[qd][dt] * gt0[qd]; prel[((qd * 4 + dt) * 2) * 64] = pk2(pv[0], pv[1]); prel[((qd * 4 + dt) * 2 + 1) * 64] = pk2(pv[2], pv[3]); }
    }
    QState st[2]; qs_init(st[0]); qs_init(st[1]);
    LAS bf16x8* qfl0 = (LAS bf16x8*)score + lane; LAS bf16x8* qfl1 = (LAS bf16x8*)(F.lds + RING_OFF + ATT_QF) + w * 128 + lane;
#pragma unroll
    for (int qd = 0; qd < 2; ++qd)
#pragma unroll
        for (int ks = 0; ks < 2; ++ks) { const v4u r = __builtin_bit_cast(v4u, qf[qd][ks]); v4u o;
            o.x = pk2(bflo(r.x) * SCL, bfhi(r.x) * SCL); o.y = pk2(bflo(r.y) * SCL, bfhi(r.y) * SCL); o.z = pk2(bflo(r.z) * SCL, bfhi(r.z) * SCL); o.w = pk2(bflo(r.w) * SCL, bfhi(r.w) * SCL);
            (qd ? qfl1 : qfl0)[ks * 64] = __builtin_bit_cast(bf16x8, o); }
    const int npair = (n + 2) / 3;
#pragma nounroll
    for (int kp = 0; kp < npair; ++kp) {
        asm volatile("s_waitcnt vmcnt(0)" ::: "memory");
        asm volatile("s_waitcnt lgkmcnt(0)" ::: "memory"); __builtin_amdgcn_s_barrier(); asm volatile("" ::: "memory");
        { const int i0 = 3 * kp + 3; if (i0 < n) ATT_ISSUE(i0); if (i0 + 1 < n) ATT_ISSUE(i0 + 1); if (i0 + 2 < n) ATT_ISSUE(i0 + 2); }
#pragma nounroll
      for (int hh = 0; hh < 3; ++hh) {
        const int it = 3 * kp + hh; if (it >= n) break;
        const LAS bf16x8* slot = (const LAS bf16x8*)(ring + (it % ATT_NS) * ATT_SLOT) + lane;
        const int j = it < nw ? jw0 + it : it - nw;
        const int D0a = qpos[0] - j * 64, D0b = qpos[1] - j * 64;
        const LAS float* lpa = lut + (1023 - D0a + 4 * kq); const LAS float* lpb = lut + (1023 - D0b + 4 * kq); const int dka = D0a - 4 * kq, dkb = D0b - 4 * kq;
        bf16x8 fr[8], frv[8], pb[2][2], qfr[2][2];
#define LOADQ() do { qfr[0][0] = qfl0[0]; qfr[0][1] = qfl0[64]; qfr[1][0] = qfl1[0]; qfr[1][1] = qfl1[64]; } while (0)
#define LOADK() do { _Pragma("unroll") for (int f = 0; f < 8; ++f) { fr[f] = slot[f * 64]; frv[f] = slot[(8 + f) * 64]; } } while (0)
#define LOADV() do { } while (0)
        if (it < nw) {
            LOADQ(); LOADK();
            if (j == cur) qk_pair<1, 1, true, true>(st, pb, qfr, fr, 0.f, 0.f, lpa, lpb, dka, dkb);
            else if (j == cur - 8) qk_pair<1, 2, true, true>(st, pb, qfr, fr, 0.f, 0.f, lpa, lpb, dka, dkb);
            else qk_pair<1, 0, true, true>(st, pb, qfr, fr, 0.f, 0.f, lpa, lpb, dka, dkb);
            LOADV(); pv_pair<true, true>(st, pb, frv);
            if (it == nw - 1) {
#pragma unroll
                for (int qd = 0; qd < 2; ++qd) { qs_finish(st[qd]); const float g2 = __builtin_bit_cast(float, __hip_atomic_load(prel + (qd - 2) * 64, RLX_AGENT));
#pragma unroll
                    for (int dt = 0; dt < 4; ++dt) { const unsigned pa = __hip_atomic_load(prel + ((qd * 4 + dt) * 2) * 64, RLX_AGENT), pc = __hip_atomic_load(prel + ((qd * 4 + dt) * 2 + 1) * 64, RLX_AGENT); const f32x4 pv = (f32x4){bflo(pa), bfhi(pa), bflo(pc), bfhi(pc)} + st[qd].o[dt] * g2; prel[((qd * 4 + dt) * 2) * 64] = pk2(pv[0], pv[1]); prel[((qd * 4 + dt) * 2 + 1) * 64] = pk2(pv[2], pv[3]); }
                    qs_init(st[qd]); }
            }
        } else {
            const bool a0 = __builtin_amdgcn_readfirstlane((int)((((j < 64 ? u0[0] : u1[0]) >> (j & 63)) & 1ull) != 0ull)) != 0, a1 = __builtin_amdgcn_readfirstlane((int)((((j < 64 ? u0[1] : u1[1]) >> (j & 63)) & 1ull) != 0ull)) != 0;
            if (a0 || a1) {
                const bool sel0 = ((selm[ql * 2 + (j >> 6)] >> (j & 63)) & 1ull) != 0ull, sel1 = ((selm[(4 + ql) * 2 + (j >> 6)] >> (j & 63)) & 1ull) != 0ull;
                LOADQ(); LOADK();
                if (t0 + w * 8 - (j * 64 + 63) >= 790) {
                    const float b31s = lut[0];
                    const float c0 = sel0 ? b31s : -1e30f, c1 = sel1 ? b31s : -1e30f;
                    if (a0 && a1) { qk_pair<0, 0, true, true>(st, pb, qfr, fr, c0, c1, lpa, lpb, dka, dkb); LOADV(); pv_pair<true, true>(st, pb, frv); }
                    else if (a0) { qk_pair<0, 0, true, false>(st, pb, qfr, fr, c0, c1, lpa, lpb, dka, dkb); LOADV(); pv_pair<true, false>(st, pb, frv); }
                    else { qk_pair<0, 0, false, true>(st, pb, qfr, fr, c0, c1, lpa, lpb, dka, dkb); LOADV(); pv_pair<false, true>(st, pb, frv); }
                } else {
                    const float c0 = sel0 ? 0.f : -1e30f, c1 = sel1 ? 0.f : -1e30f;
                    if (j == cur) { qk_pair<1, 1, true, true>(st, pb, qfr, fr, c0, c1, lpa, lpb, dka, dkb); LOADV(); pv_pair<true, true>(st, pb, frv); }
                    else if (a0 && a1) { qk_pair<1, 0, true, true>(st, pb, qfr, fr, c0, c1, lpa, lpb, dka, dkb); LOADV(); pv_pair<true, true>(st, pb, frv); }
                    else if (a0) { qk_pair<1, 0, true, false>(st, pb, qfr, fr, c0, c1, lpa, lpb, dka, dkb); LOADV(); pv_pair<true, false>(st, pb, frv); }
                    else { qk_pair<1, 0, false, true>(st, pb, qfr, fr, c0, c1, lpa, lpb, dka, dkb); LOADV(); pv_pair<false, true>(st, pb, frv); }
                }
            }
        }
#undef LOADK
#undef LOADQ
#undef LOADV
      }
    }
#undef ATT_ISSUE
    int lane2 = lane; asm volatile("" : "+v"(lane2)); const int kq2 = lane2 >> 4, h2 = lane2 & 3, ql2 = (lane2 & 15) >> 2;
#pragma unroll
    for (int qd = 0; qd < 2; ++qd) {
        qs_finish(st[qd]);
        const int row = b * T + t0 + w * 8 + qd * 4 + ql2, head = 4 * g + h2;
        const bf16* pr = PROJ + (size_t)row * NPA; bf16* YCAT = (bf16*)(F.ws + WS_ACT2);
        const float g1 = __builtin_bit_cast(float, __hip_atomic_load(prel + (qd - 4) * 64, RLX_AGENT));
#pragma unroll
        for (int dt = 0; dt < 4; ++dt) { const int dim = dt * 16 + kq2 * 4; const v2u z = *(const v2u*)(pr + CZN + head * 64 + dim);
            v2u pq; pq.x = __hip_atomic_load(prel + ((qd * 4 + dt) * 2) * 64, RLX_AGENT); pq.y = __hip_atomic_load(prel + ((qd * 4 + dt) * 2 + 1) * 64, RLX_AGENT); const f32x4 o = (f32x4){bflo(pq.x), bfhi(pq.x), bflo(pq.y), bfhi(pq.y)} + st[qd].o[dt] * g1;
            v2u wv; wv.x = pk2(o[0] * fsilu(bflo(z.x)), o[1] * fsilu(bfhi(z.x))); wv.y = pk2(o[2] * fsilu(bflo(z.y)), o[3] * fsilu(bfhi(z.y)));
            *(v2u*)(YCAT + (size_t)row * D + head * 64 + dim) = wv; }
    }
}

template <class RowF> __device__ __forceinline__ void build_k_f32(bf16x8 (&kf)[8], const RowF& rowp, int lane) {
    const int r16 = lane & 15, kq = lane >> 4;
#pragma unroll
    for (int f = 0; f < 8; ++f) { const int kt = f >> 1, ks = f & 1; const float* p = rowp(kt * 16 + r16) + ks * 32 + kq * 8; kf[f] = pack8(__builtin_nontemporal_load((const f32x4*)p), __builtin_nontemporal_load((const f32x4*)(p + 4))); }
}
template <class RowF> __device__ __forceinline__ void build_v_f32(bf16x8 (&vf)[8], const RowF& rowp, int lane) {
    const int r16 = lane & 15, kq = lane >> 4;
#pragma unroll
    for (int f = 0; f < 8; ++f) { const int dt = f >> 1, ks2 = f & 1; f32x4 lo, hi;
#pragma unroll
        for (int e = 0; e < 4; ++e) { lo[e] = __builtin_nontemporal_load(rowp(vkey(ks2, kq, e)) + dt * 16 + r16); hi[e] = __builtin_nontemporal_load(rowp(vkey(ks2, kq, e + 4)) + dt * 16 + r16); }
        vf[f] = pack8(lo, hi); }
}
template <class KRowF, class VRowF> __device__ __forceinline__ void build_kv_f32(bf16x8 (&kf)[8], bf16x8 (&vf)[8], const KRowF& krow, const VRowF& vrow, LAS bf16* tile  , int lane) {
    const int r16 = lane & 15, kq = lane >> 4;
    f32x4 vr[16], kr[16];
#pragma unroll
    for (int i = 0; i < 16; ++i) vr[i] = __builtin_nontemporal_load((const f32x4*)(vrow(i * 4 + kq) + r16 * 4));
#pragma unroll
    for (int f = 0; f < 8; ++f) { const int kt = f >> 1, ks = f & 1; const float* p = krow(kt * 16 + r16) + ks * 32 + kq * 8; kr[2 * f] = __builtin_nontemporal_load((const f32x4*)p); kr[2 * f + 1] = __builtin_nontemporal_load((const f32x4*)(p + 4)); }
#pragma unroll
    for (int hv = 0; hv < 2; ++hv) {
#pragma unroll
        for (int i = 0; i < 8; ++i) { const f32x4 x = vr[hv * 8 + i]; v2u o; o.x = pk2(x[0], x[1]); o.y = pk2(x[2], x[3]); *(LAS v2u*)(tile + (i * 4 + kq) * 72 + r16 * 4) = o; }
        LDS_WAIT(); asm volatile("" ::: "memory");
#pragma unroll
        for (int dt = 0; dt < 4; ++dt) { unsigned short v[8];
#pragma unroll
            for (int e = 0; e < 8; ++e) v[e] = tile[((e >> 2) * 16 + kq * 4 + (e & 3)) * 72 + dt * 16 + r16];
            v4u o; o.x = v[0] | ((unsigned)v[1] << 16); o.y = v[2] | ((unsigned)v[3] << 16); o.z = v[4] | ((unsigned)v[5] << 16); o.w = v[6] | ((unsigned)v[7] << 16);
            vf[dt * 2 + hv] = __builtin_bit_cast(bf16x8, o); }
        LDS_WAIT(); asm volatile("" ::: "memory");
    }
#pragma unroll
    for (int f = 0; f < 8; ++f) kf[f] = pack8(kr[2 * f], kr[2 * f + 1]);
}
__device__ __forceinline__ void build_new(bf16x8 (&kf)[8], bf16x8 (&vf)[8], const bf16* PROJ, int rowbase, int kcol, int vcol, int lane) {
    const int r16 = lane & 15, kq = lane >> 4;
#pragma unroll
    for (int f = 0; f < 8; ++f) { const int kt = f >> 1, ks = f & 1;
        kf[f] = (kt == 0 && r16 < 4) ? *(const bf16x8*)(PROJ + (size_t)(rowbase + r16) * NPA + kcol + ks * 32 + kq * 8) : zero8(); }
#pragma unroll
    for (int f = 0; f < 8; ++f) { const int dt = f >> 1, ks2 = f & 1; v4u o = {0u, 0u, 0u, 0u};
        if (ks2 == 0 && kq == 0) { unsigned short v[4];
#pragma unroll
            for (int e = 0; e < 4; ++e) v[e] = PROJ[(size_t)(rowbase + e) * NPA + vcol + dt * 16 + r16];
            o.x = v[0] | ((unsigned)v[1] << 16); o.y = v[2] | ((unsigned)v[3] << 16); }
        vf[f] = __builtin_bit_cast(bf16x8, o); }
}
constexpr int SMP_W = 110592, SMP_PE = SMP_W + 2 * 4096 * 4, SMP_VEC = SMP_PE + 2 * 64 * 4, SMP_KS = SMP_VEC + 8 * 64 * 4, SMP_VS = SMP_KS + 4096;
static_assert(ATT_MERGE + 8 * 2 * 18 * 64 * 4 <= SMP_W && SMP_VS + 4096 <= SCRATCH_BYTES, "sample unit LDS map");
__device__ __forceinline__ void sample_summaries(Frame& F, int a, int s, int g) {
    const int w = F.wave;
    LAS float* Wl = (LAS float*)(F.lds + RING_OFF + SMP_W); LAS float* pem = (LAS float*)(F.lds + RING_OFF + SMP_PE); LAS float* vec = (LAS float*)(F.lds + RING_OFF + SMP_VEC) + w * 64;
    LAS bf16* ks = (LAS bf16*)(F.lds + RING_OFF + SMP_KS); LAS bf16* vs = (LAS bf16*)(F.lds + RING_OFF + SMP_VS);
    const int rg = F.lane >> 4, c4 = F.lane & 15;
    const float* cache = F.cache_nsa();
    const int pagev = F.page_table()[s * NPAGES + (F.lane & 15)];
    f32x4 l0[16], l1[16];
#define SMP_BASE(j_) (cache + ((((size_t)(a * N_POOL + __builtin_amdgcn_readlane(pagev, (j_) >> 1)) * 128 + ((j_) & 1) * 64) * 4 + 0) * 2 + g) * 64 + 4 * c4)
#define SMP_LOAD(dst, p_) do { const float* b_ = (p_); _Pragma("unroll") for (int i = 0; i < 16; ++i) dst[i] = __builtin_nontemporal_load((const f32x4*)(b_ + (size_t)(4 * i + rg) * 512)); } while (0)
    SMP_LOAD(l0, SMP_BASE(w)); SMP_LOAD(l1, SMP_BASE(w) + 128);
    { const float* wc = F.w_cmp() + (size_t)a * 2 * 4096;
      for (int e = F.tid; e < 2 * 4096; e += NWAVES * 64) Wl[e] = wc[e];
      if (F.tid < 128) pem[F.tid] = ((const float*)(F.ws + WS_PEM))[a * 128 + F.tid];
      LDS_WAIT(); __syncthreads(); }
#define SMP_REDUCE(src, kv_, j_) do { f32x4 acc = {0.f, 0.f, 0.f, 0.f}; _Pragma("unroll") for (int i = 0; i < 16; ++i) acc += src[i]; \
        _Pragma("unroll") for (int q = 0; q < 4; ++q) { acc[q] += __shfl_xor(acc[q], 16); acc[q] += __shfl_xor(acc[q], 32); } \
        if (F.lane < 16) { _Pragma("unroll") for (int q = 0; q < 4; ++q) vec[c4 * 4 + q] = acc[q] * (1.0f / 64.0f) + pem[(kv_) * 64 + c4 * 4 + q]; } \
        LDS_WAIT(); asm volatile("" ::: "memory"); } while (0)
#pragma unroll
    for (int r = 0; r < 4; ++r) {
        const int j = w + 8 * r;
        SMP_REDUCE(l0, 0, j);
        if (r < 3) SMP_LOAD(l0, SMP_BASE(j + 8));
        cmp_matvec_store(F, 0, vec, ks, vs, j, 1, SMP_W);
        LDS_WAIT(); asm volatile("" ::: "memory");
        SMP_REDUCE(l1, 1, j);
        if (r < 3) SMP_LOAD(l1, SMP_BASE(j + 8) + 128);
        cmp_matvec_store(F, 1, vec, ks, vs, j, 1, SMP_W);
        LDS_WAIT(); asm volatile("" ::: "memory");
    }
#undef SMP_REDUCE
#undef SMP_LOAD
#undef SMP_BASE
    LDS_WAIT(); __syncthreads();
}
__device__ __forceinline__ void attn_sample_unit(Frame& F, int a, int s, int g) {
    sample_summaries(F, a, s, g); relaunder(F);
#ifdef PROBE_SUM
    __syncthreads(); sample_summaries(F, a, s, g); relaunder(F);
#endif
    const bf16* PROJ = (const bf16*)(F.ws + WS_PROJ);
    const int lane = F.lane, w = F.wave, kq = lane >> 4, c = lane & 15, ql = c >> 2, h = c & 3;
    const LAS float* lut = (const LAS float*)(F.lds + RING_OFF + ATT_LUT) + h * ATT_LUTN;
    LAS float* score = (LAS float*)(F.lds + RING_OFF + ATT_SCORE) + w * 512;
    LAS float* merge = (LAS float*)(F.lds + RING_OFF + ATT_MERGE);
    const int rowbase = MP + s * 4, qpos = PAST + ql, row = rowbase + ql;
    const int pagev = F.page_table()[s * NPAGES + (lane & 15)];
    LAS bf16* vtile = (LAS bf16*)(F.lds + RING_OFF + SMP_W) + w * (32 * 72);
    bf16x8 qf[2];
#pragma unroll
    for (int ks = 0; ks < 2; ++ks) qf[ks] = *(const bf16x8*)(PROJ + (size_t)row * NPA + CQ + (4 * g + h) * 64 + ks * 32 + kq * 8);
    f32x4 oc[4];
    quad_cmp<2, 1>(oc, qf, (const LAS bf16x8*)(F.lds + RING_OFF + SMP_KS), (const LAS bf16x8*)(F.lds + RING_OFF + SMP_VS), 2, qpos, lut, score, lane);
    LDS_WAIT(); asm volatile("" ::: "memory");
    unsigned long long my0 = 0ull, u0 = 0ull;
#pragma unroll
    for (int q = 0; q < 4; ++q) { unsigned long long m0, m1; select_blocks(score + q * 128, 32, lane, m0, m1); u0 |= m0; if (q == ql) my0 = m0; }
    LDS_WAIT(); __syncthreads();
    if (w == 0) { LAS float* op = (LAS float*)(F.lds + RING_OFF + ATT_SCORE) + lane;
#pragma unroll
        for (int dt = 0; dt < 4; ++dt)
#pragma unroll
            for (int i = 0; i < 4; ++i) op[(dt * 4 + i) * 64] = oc[dt][i]; }
    QState st; qs_init(st);
    int item = 0;
#define SMP_PARK(br_) do { LAS float* mp = merge + (size_t)((w * 2 + (br_)) * 18) * 64 + lane; mp[0] = st.m; mp[64] = st.l; \
        _Pragma("unroll") for (int dt = 0; dt < 4; ++dt) { _Pragma("unroll") for (int i = 0; i < 4; ++i) mp[(2 + dt * 4 + i) * 64] = st.o[dt][i]; } } while (0)
    { unsigned long long um = u0 & 0xffffffffull;
      while (um) { const int j = __builtin_ctzll(um); um &= um - 1ull;
        if ((item++ & 7) == w) {
            const int page = __builtin_amdgcn_readlane(pagev, j >> 1);
            const float* kb = F.cache_nsa() + ((((size_t)(a * N_POOL + page) * 128 + (j & 1) * 64) * 4 + 2) * 2 + g) * 64;
            auto kr = [&](int key) { return kb + (size_t)key * 512; }; auto vr = [&](int key) { return kb + 128 + (size_t)key * 512; };
            bf16x8 kf[8], vf[8], pb[2]; build_kv_f32(kf, vf, kr, vr, vtile, lane); quad_qk<0>(st, pb, qf, kf, qpos, j * 64, ((my0 >> j) & 1ull) != 0ull, lut, kq); quad_pv(st, pb, vf);
        } } }
    if ((item++ & 7) == w) { bf16x8 kf[8], vf[8]; build_new(kf, vf, PROJ, rowbase, CKV + 2 * 128 + g * 64, CKV + 3 * 128 + g * 64, lane); bf16x8 pb[2]; quad_qk<0>(st, pb, qf, kf, qpos, PAST, true, lut, kq); quad_pv(st, pb, vf); }
    SMP_PARK(0); qs_init(st);
    for (int jb = 0; jb < 8; ++jb)
        if ((item++ & 7) == w) {
            const float* kb = F.cache_win() + ((((size_t)(a * DEC_B + s) * 512 + jb * 64) * 2 + 0) * 2 + g) * 64;
            auto kr = [&](int key) { return kb + (size_t)key * 256; }; auto vr = [&](int key) { return kb + 128 + (size_t)key * 256; };
            bf16x8 kf[8], vf[8], pb[2]; build_kv_f32(kf, vf, kr, vr, vtile, lane); quad_qk<1>(st, pb, qf, kf, qpos, PAST - 512 + jb * 64, true, lut, kq); quad_pv(st, pb, vf);
        }
    if ((item++ & 7) == w) { bf16x8 kf[8], vf[8]; build_new(kf, vf, PROJ, rowbase, CKV + 4 * 128 + g * 64, CKV + 5 * 128 + g * 64, lane); bf16x8 pb[2]; quad_qk<1>(st, pb, qf, kf, qpos, PAST, true, lut, kq); quad_pv(st, pb, vf); }
    SMP_PARK(1);
#undef SMP_PARK
    LDS_WAIT(); __syncthreads();
    if (w == 0) {
        f32x4 ob[2][4];
#pragma unroll
        for (int br = 0; br < 2; ++br) {
            float mm = -1e30f;
#pragma unroll
            for (int ww = 0; ww < 8; ++ww) mm = fmaxf(mm, merge[(size_t)((ww * 2 + br) * 18) * 64 + lane]);
            float l = 0.f; f32x4 o[4];
#pragma unroll
            for (int dt = 0; dt < 4; ++dt) o[dt] = (f32x4){0.f, 0.f, 0.f, 0.f};
#pragma unroll
            for (int ww = 0; ww < 8; ++ww) { const LAS float* mp = merge + (size_t)((ww * 2 + br) * 18) * 64 + lane; const float sc = fexp2(mp[0] - mm); l += mp[64] * sc;
#pragma unroll
                for (int dt = 0; dt < 4; ++dt)
#pragma unroll
                    for (int i = 0; i < 4; ++i) o[dt][i] += mp[(2 + dt * 4 + i) * 64] * sc; }
            l = xrow16_sum(l); const float inv = l > 0.f ? 1.0f / l : 0.f;
#pragma unroll
            for (int dt = 0; dt < 4; ++dt) ob[br][dt] = o[dt] * inv;
        }
        f32x4 oc2[4]; { const LAS float* op = (const LAS float*)(F.lds + RING_OFF + ATT_SCORE) + lane;
#pragma unroll
            for (int dt = 0; dt < 4; ++dt)
#pragma unroll
                for (int i = 0; i < 4; ++i) oc2[dt][i] = op[(dt * 4 + i) * 64]; }
        int lane2 = lane; asm volatile("" : "+v"(lane2));
        nsa_store(F, a, rowbase + ((lane2 & 15) >> 2), 4 * g + (lane2 & 3), oc2, ob[0], ob[1], lane2 >> 4);
    }
}
constexpr int GM_STAT = 0, GM_VNT = 2048, GM_VSTRIDE = 136;
__device__ __forceinline__ void gmlp_prompt_unit(Frame& F, int a, int chunk, int g) {
    const bf16* PROJ = (const bf16*)(F.ws + WS_PROJ); bf16* YCAT = (bf16*)(F.ws + WS_ACT2);
    const int lane = F.lane, w = F.wave, row0 = chunk * 128, r16 = lane & 15, kq = lane >> 4, nks = (w >> 1) + 1;
    LAS bf16* vnt = (LAS bf16*)(F.lds + RING_OFF + GM_VNT);
    v4u raws[16];
#pragma unroll
    for (int tt = 0; tt < 16; ++tt) raws[tt] = *(const v4u*)(PROJ + (size_t)(row0 + w * 16 + tt) * NPA + CV + lane * 8);
    const bf16* Wsp = (const bf16*)(F.ws + WS_WSP) + (size_t)(a * 4 + g) * 128 * 128;
    bf16x8 bfr[4];
#pragma unroll
    for (int ks = 0; ks < 4; ++ks) bfr[ks] = (ks < nks) ? *(const bf16x8*)(Wsp + (size_t)(w * 16 + r16) * 128 + ks * 32 + kq * 8) : zero8();
    const int tok_e = w * 16 + r16, row_e = row0 + tok_e; v2u uu[8], zz[8];
    const float bs = F.b_sp()[(a * 4 + g) * 128 + tok_e];
    float lg[8], lb[8];
    { const float* pg = F.ln_g() + a * 512 + lane * 8; const float* pb = F.ln_b() + a * 512 + lane * 8;
#pragma unroll
      for (int e = 0; e < 8; ++e) { lg[e] = pg[e]; lb[e] = pb[e]; } }
    float mu[16], rs[16];
#pragma unroll
    for (int tt = 0; tt < 16; ++tt) { const v4u raw = raws[tt]; mu[tt] = ((bflo(raw.x) + bfhi(raw.x)) + (bflo(raw.y) + bfhi(raw.y))) + ((bflo(raw.z) + bfhi(raw.z)) + (bflo(raw.w) + bfhi(raw.w))); }
#pragma unroll
    for (int tt = 0; tt < 16; ++tt) { float x = mu[tt]; x += dpp_q<0xB1>(x); x += dpp_q<0x4E>(x); x += dpp_q<0x124>(x); x += dpp_q<0x128>(x); mu[tt] = x; }
#pragma unroll
    for (int o = 16; o < 64; o <<= 1)
#pragma unroll
        for (int tt = 0; tt < 16; ++tt) mu[tt] += __shfl_xor(mu[tt], o);
#pragma unroll
    for (int tt = 0; tt < 16; ++tt) { mu[tt] *= (1.0f / 512.0f); const v4u raw = raws[tt]; const float m = mu[tt];
        const float d0 = bflo(raw.x) - m, d1 = bfhi(raw.x) - m, d2 = bflo(raw.y) - m, d3 = bfhi(raw.y) - m, d4 = bflo(raw.z) - m, d5 = bfhi(raw.z) - m, d6 = bflo(raw.w) - m, d7 = bfhi(raw.w) - m;
        rs[tt] = ((d0 * d0 + d1 * d1) + (d2 * d2 + d3 * d3)) + ((d4 * d4 + d5 * d5) + (d6 * d6 + d7 * d7)); }
#pragma unroll
    for (int tt = 0; tt < 16; ++tt) { float x = rs[tt]; x += dpp_q<0xB1>(x); x += dpp_q<0x4E>(x); x += dpp_q<0x124>(x); x += dpp_q<0x128>(x); rs[tt] = x; }
#pragma unroll
    for (int o = 16; o < 64; o <<= 1)
#pragma unroll
        for (int tt = 0; tt < 16; ++tt) rs[tt] += __shfl_xor(rs[tt], o);
    if ((lane >> 4) == g) {
#pragma unroll
        for (int tt = 0; tt < 16; ++tt) { const int tok = w * 16 + tt; const v4u raw = raws[tt]; const float m = mu[tt], rstd = rsqrtf(rs[tt] * (1.0f / 512.0f) + EPS);
            const float v[8] = {bflo(raw.x), bfhi(raw.x), bflo(raw.y), bfhi(raw.y), bflo(raw.z), bfhi(raw.z), bflo(raw.w), bfhi(raw.w)};
#pragma unroll
            for (int e = 0; e < 8; ++e) vnt[((lane & 15) * 8 + e) * GM_VSTRIDE + tok] = (bf16)f2bf((v[e] - m) * rstd * lg[e] + lb[e]); }
    }
    LDS_WAIT(); __syncthreads();
#pragma unroll
    for (int dt = 0; dt < 8; ++dt) { const int ch = g * 128 + dt * 16 + kq * 4; uu[dt] = *(const v2u*)(PROJ + (size_t)row_e * NPA + CU + ch); zz[dt] = *(const v2u*)(PROJ + (size_t)row_e * NPA + CZG + ch); }
    f32x4 acc[8];
#pragma unroll
    for (int dt = 0; dt < 8; ++dt) acc[dt] = (f32x4){0.f, 0.f, 0.f, 0.f};
#pragma unroll
    for (int ks = 0; ks < 4; ++ks) {
        if (ks < nks) {
#pragma unroll
            for (int dt = 0; dt < 8; ++dt) { const bf16x8 afr = *(const LAS bf16x8*)(vnt + (dt * 16 + r16) * GM_VSTRIDE + ks * 32 + kq * 8); acc[dt] = mfma16(afr, bfr[ks], acc[dt]); } }
    }
#pragma unroll
    for (int dt = 0; dt < 8; ++dt) { const int ch = g * 128 + dt * 16 + kq * 4; const v2u u = uu[dt], z = zz[dt];
        v2u o; o.x = pk2(bflo(u.x) * (acc[dt][0] + bs) * fsilu(bflo(z.x)), bfhi(u.x) * (acc[dt][1] + bs) * fsilu(bfhi(z.x)));
        o.y = pk2(bflo(u.y) * (acc[dt][2] + bs) * fsilu(bflo(z.y)), bfhi(u.y) * (acc[dt][3] + bs) * fsilu(bfhi(z.y)));
        *(v2u*)(YCAT + (size_t)row_e * D + 512 + ch) = o; }
}
__device__ __forceinline__ void gmlp_sample_unit(Frame& F, int a, int su) {
    const bf16* PROJ = (const bf16*)(F.ws + WS_PROJ); bf16* YCAT = (bf16*)(F.ws + WS_ACT2);
    const int lane = F.lane, w = F.wave, srow = su * 8 + w, row = MP + srow, t = srow & 3;
    LAS float* vn = (LAS float*)(F.lds + RING_OFF);
    const v4u raw = *(const v4u*)(PROJ + (size_t)row * NPA + CV + lane * 8);
    float v[8] = {bflo(raw.x), bfhi(raw.x), bflo(raw.y), bfhi(raw.y), bflo(raw.z), bfhi(raw.z), bflo(raw.w), bfhi(raw.w)};
    float s = 0.f;
#pragma unroll
    for (int e = 0; e < 8; ++e) s += v[e];
    const float mu = wave_sum(s) * (1.0f / 512.0f); float q = 0.f;
#pragma unroll
    for (int e = 0; e < 8; ++e) { const float dlt = v[e] - mu; q += dlt * dlt; }
    const float rstd = rsqrtf(wave_sum(q) * (1.0f / 512.0f) + EPS);
    float* gv = F.out + O_GV + ((size_t)a * MS + srow) * 512 + lane * 8;
#pragma unroll
    for (int e = 0; e < 8; ++e) { const float x = (v[e] - mu) * rstd * F.ln_g()[a * 512 + lane * 8 + e] + F.ln_b()[a * 512 + lane * 8 + e]; v[e] = x; vn[w * 512 + lane * 8 + e] = x; gv[e] = x; }
    LDS_WAIT(); __syncthreads();
    const int g = lane >> 4;
    float mix[8];
#pragma unroll
    for (int e = 0; e < 8; ++e) mix[e] = F.b_sp()[(a * 4 + g) * 128 + t];
    for (int j = 0; j <= t; ++j) { const float wv = F.w_sp()[((size_t)(a * 4 + g) * 128 + t) * 128 + j]; const LAS float* vj = vn + (w - t + j) * 512 + lane * 8;
#pragma unroll
        for (int e = 0; e < 8; ++e) mix[e] += wv * vj[e]; }
    const v4u u = *(const v4u*)(PROJ + (size_t)row * NPA + CU + lane * 8), z = *(const v4u*)(PROJ + (size_t)row * NPA + CZG + lane * 8);
    v4u o;
    o.x = pk2(bflo(u.x) * mix[0] * fsilu(bflo(z.x)), bfhi(u.x) * mix[1] * fsilu(bfhi(z.x)));
    o.y = pk2(bflo(u.y) * mix[2] * fsilu(bflo(z.y)), bfhi(u.y) * mix[3] * fsilu(bfhi(z.y)));
    o.z = pk2(bflo(u.z) * mix[4] * fsilu(bflo(z.z)), bfhi(u.z) * mix[5] * fsilu(bfhi(z.z)));
    o.w = pk2(bflo(u.w) * mix[6] * fsilu(bflo(z.w)), bfhi(u.w) * mix[7] * fsilu(bfhi(z.w)));
    *(v4u*)(YCAT + (size_t)row * D + 512 + lane * 8) = o;
}

#ifndef PROBE_ATT
#define PROBE_ATT 0
#endif
__device__ __forceinline__ void p_attn(Frame& F, int a) {
    constexpr int N_SA = DEC_B * 2, N_PA = BATCH * 2 * 128, N_GP = 128 * 4, N_GS = MS / 8;
    int ns = 0, np = 0;
    for (int r = F.vcu; r < N_SA; r += F.G) ++ns;
    for (int r = F.vcu; r < N_PA; r += F.G) ++np;
    const int pos = (F.vcu >> 3) & 3;
    const int ins = ns == 0 ? -1 : (pos < np ? pos : np);
    int lut_g = -1;
    for (int k = 0; k < np + ns; ++k) {
        int arg; bool smp;
        if (k == ins) { smp = true; arg = F.vcu; }
        else { const int idx = (ns > 0 && k > ins) ? k - 1 : k;
            if (idx >= np) { smp = true; arg = F.vcu + F.G * (idx - np + 1); } else { smp = false; arg = F.vcu + F.G * idx; } }
        __syncthreads(); relaunder(F);
        int g, b = 0, s = 0, qt = 0;
        if (smp) { s = arg >> 1; g = arg & 1; }
        else {
            const int r = arg, kk = r >> 8, x = (r >> 5) & 7, i = r & 31, ci = (x >> 2) * 32 + i;
            b = (x >> 1) & 1; g = x & 1; qt = kk ? ci : 127 - ci; }
        if (g != lut_g) { build_lut(F, g); lut_g = g; }
        LDS_WAIT(); __syncthreads();
        if (smp) attn_sample_unit(F, a, s, g); else attn_prompt_unit(F, a, b, g, qt);
    }
    gu32* qh = F.ctl + CW_GQ + a;
    for (;;) {
        __syncthreads(); relaunder(F);
        if (F.tid == 0) F.MISC[16] = __hip_atomic_fetch_add((unsigned*)qh, 1u, __ATOMIC_RELAXED, __HIP_MEMORY_SCOPE_AGENT);
        LDS_WAIT(); __syncthreads();
        const int idx = __builtin_amdgcn_readfirstlane((int)F.MISC[16]);
        if (idx >= N_GP + N_GS) break;
        if (idx < N_GP) gmlp_prompt_unit(F, a, idx >> 2, idx & 3); else gmlp_sample_unit(F, a, idx - N_GP);
    }
}
constexpr int LR_XC = 0, LR_XF = 17408, LR_AA = LR_XF + 64 * 129 * 4, LR_SEG = LR_AA + 64 * 129 * 4;
template <int MODE>
__device__ __forceinline__ void lru_unit(Frame& F, int c, int chunk  , int hd) {
    const bf16* XBZ = (const bf16*)(F.ws + WS_PROJ); bf16* YL = (bf16*)(F.ws + WS_ACT2);
    const int tid = F.tid, lane = F.lane, w = F.wave;
    LAS bf16* xc = (LAS bf16*)(F.lds + RING_OFF + LR_XC); LAS float* xf = (LAS float*)(F.lds + RING_OFF + LR_XF); LAS float* aa = (LAS float*)(F.lds + RING_OFF + LR_AA); LAS float* seg = (LAS float*)(F.lds + RING_OFF + LR_SEG);
    const int ch = tid & 127, sg = tid >> 7, chg = hd * 128 + ch;
    const int row0 = (MODE == 2) ? MP + chunk * 64 : chunk * 64;
    {
        const float cw0 = F.conv_w()[(c * 4 + 0) * 1024 + chg], cw1 = F.conv_w()[(c * 4 + 1) * 1024 + chg], cw2 = F.conv_w()[(c * 4 + 2) * 1024 + chg], cw3 = F.conv_w()[(c * 4 + 3) * 1024 + chg], cb = F.conv_b()[c * 1024 + chg];
        unsigned short xr[16]; float h3 = 0.f, h2 = 0.f, h1 = 0.f;
#pragma unroll
        for (int r = 0; r < 16; ++r) xr[r] = XBZ[(size_t)(row0 + sg * 16 + r) * 2048 + chg];
        if (MODE != 2) { const int tb = (chunk & 127) * 64 + sg * 16;
            if (tb >= 3) { const bf16* p = XBZ + (size_t)(row0 + sg * 16 - 3) * 2048 + chg; h3 = bf2f(p[0]); h2 = bf2f(p[2048]); h1 = bf2f(p[4096]); } }
        float cs[4][3];
        if (MODE == 2) {
#pragma unroll
            for (int q = 0; q < 4; ++q) { const int s = chunk * 16 + sg * 4 + q; const float* cp = F.state_conv() + ((size_t)(c * DEC_B + s) * 3) * 1024 + chg; cs[q][0] = cp[0]; cs[q][1] = cp[1024]; cs[q][2] = cp[2048]; } }
        float x3 = h3, x2 = h2, x1 = h1;
#pragma unroll
        for (int r = 0; r < 16; ++r) {
            const int rr = sg * 16 + r;
            if (MODE == 2 && (r & 3) == 0) { x3 = cs[r >> 2][0]; x2 = cs[r >> 2][1]; x1 = cs[r >> 2][2]; }
            const float x0 = bf2f(xr[r]);
            const float v = cb + cw0 * x3 + cw1 * x2 + cw2 * x1 + cw3 * x0;
            xf[rr * 129 + ch] = v; xc[rr * 136 + ch] = (bf16)f2bf(v);
            x3 = x2; x2 = x1; x1 = x0;
        }
    }
    LDS_WAIT(); __syncthreads();
    {
        const int r16 = lane & 15, kq = lane >> 4;
        const bf16* WG = (const bf16*)(F.ws + WS_WG) + (size_t)(c * 8 + hd) * 256 * 128;
        f32x4 acc[2][4];
#pragma unroll
        for (int i = 0; i < 2; ++i)
#pragma unroll
            for (int tt = 0; tt < 4; ++tt) acc[i][tt] = (f32x4){0.f, 0.f, 0.f, 0.f};
#pragma unroll
        for (int ks = 0; ks < 4; ++ks) {
            const bf16x8 a0 = *(const bf16x8*)(WG + (size_t)(w * 16 + r16) * 128 + ks * 32 + kq * 8), a1 = *(const bf16x8*)(WG + (size_t)(128 + w * 16 + r16) * 128 + ks * 32 + kq * 8);
#pragma unroll
            for (int tt = 0; tt < 4; ++tt) { const bf16x8 bq = *(const LAS bf16x8*)(xc + (tt * 16 + r16) * 136 + ks * 32 + kq * 8); acc[0][tt] = mfma16(a0, bq, acc[0][tt]); acc[1][tt] = mfma16(a1, bq, acc[1][tt]); }
        }
#pragma unroll
        for (int i = 0; i < 4; ++i) {
            const int cl = w * 16 + kq * 4 + i, cg = hd * 128 + cl;
            const float bra = F.b_rg_a()[c * 1024 + cg], brx = F.b_rg_x()[c * 1024 + cg], lm = F.lam()[c * 1024 + cg];
            const float sp = log1pf(expf(-lm));
#pragma unroll
            for (int tt = 0; tt < 4; ++tt) {
                const int t = tt * 16 + r16;
                const float rg = fsigmoid(acc[0][tt][i] + bra), ig = fsigmoid(acc[1][tt][i] + brx);
                const float av = fexp2(-8.0f * LOG2E * rg * sp), mult = __builtin_amdgcn_sqrtf(fmaxf(1.0f - av * av, 0.f));
                const float xv = xf[t * 129 + cl];
                aa[t * 129 + cl] = av; xf[t * 129 + cl] = mult * ig * xv;
            }
        }
    }
    LDS_WAIT(); __syncthreads();
    if (MODE == 2) {
        float* hout = F.out + O_HS + (size_t)c * DEC_B * 1024;
        unsigned short zr[16]; float h0v[4];
#pragma unroll
        for (int r = 0; r < 16; ++r) zr[r] = XBZ[(size_t)(row0 + sg * 16 + r) * 2048 + 1024 + chg];
#pragma unroll
        for (int q = 0; q < 4; ++q) h0v[q] = F.state_h()[((size_t)c * DEC_B + chunk * 16 + sg * 4 + q) * 1024 + chg];
#pragma unroll
        for (int q = 0; q < 4; ++q) { const int s = chunk * 16 + sg * 4 + q; float hh = h0v[q];
#pragma unroll
            for (int t = 0; t < 4; ++t) { const int rr = sg * 16 + q * 4 + t; hh = aa[rr * 129 + ch] * hh + xf[rr * 129 + ch];
                YL[(size_t)(row0 + rr) * D + chg] = (bf16)f2bf(hh * fsilu(bf2f(zr[q * 4 + t]))); }
            hout[(size_t)s * 1024 + chg] = hh; }
    } else {
        float P = 1.f, H = 0.f;
#pragma unroll 4
        for (int r = 0; r < 16; ++r) { const int rr = sg * 16 + r; const float av = aa[rr * 129 + ch]; H = av * H + xf[rr * 129 + ch]; P *= av; }
        seg[(sg * 128 + ch) * 2] = P; seg[(sg * 128 + ch) * 2 + 1] = H;
        LDS_WAIT(); __syncthreads();
        if (MODE == 0) {
            if (sg == 0) { float Pc = 1.f, Hc = 0.f;
#pragma unroll
                for (int s2 = 0; s2 < 4; ++s2) { const float p = seg[(s2 * 128 + ch) * 2], hq = seg[(s2 * 128 + ch) * 2 + 1]; Hc = p * Hc + hq; Pc *= p; }
                float* ls = (float*)(F.ws + WS_LSUM) + ((size_t)chunk * 1024 + chg) * 2; ls[0] = Pc; ls[1] = Hc; }
        } else {
            float hh = ((const float*)(F.ws + WS_CARRY))[(size_t)chunk * 1024 + chg];
            unsigned short zr[16];
#pragma unroll
            for (int r = 0; r < 16; ++r) zr[r] = XBZ[(size_t)(row0 + sg * 16 + r) * 2048 + 1024 + chg];
            for (int s2 = 0; s2 < sg; ++s2) hh = seg[(s2 * 128 + ch) * 2] * hh + seg[(s2 * 128 + ch) * 2 + 1];
#pragma unroll
            for (int r = 0; r < 16; ++r) { const int rr = sg * 16 + r; hh = aa[rr * 129 + ch] * hh + xf[rr * 129 + ch];
                YL[(size_t)(row0 + rr) * D + chg] = (bf16)f2bf(hh * fsilu(bf2f(zr[r]))); }
        }
    }
}
__device__ __forceinline__ void lru_seg_task(Frame& F, int c, int b, int hd, int sgm) {
    const bf16* XBZ = (const bf16*)(F.ws + WS_PROJ); unsigned* HP = (unsigned*)(F.ws + WS_HP);
    const int tid = F.tid, lane = F.lane, w = F.wave;
    constexpr int XL = 132;
    LAS bf16* xc = (LAS bf16*)(F.lds + RING_OFF); LAS float* xf = (LAS float*)(F.lds + RING_OFF + 17408); LAS float* aa = xf + 64 * XL; LAS float* seg = aa + 64 * XL;
    const int ch = tid & 127, sg = tid >> 7, chg = hd * 128 + ch, r16 = lane & 15, kq = lane >> 4;
    const int cq = tid & 31, rq = tid >> 5, cg4 = hd * 128 + cq * 4;
    f32x4 cw[4], cbv;
#pragma unroll
    for (int k = 0; k < 4; ++k) cw[k] = *(const f32x4*)(F.conv_w() + (c * 4 + k) * 1024 + cg4);
    cbv = *(const f32x4*)(F.conv_b() + c * 1024 + cg4);
    bf16x8 wa[4], wx[4];
    { const bf16* WG = (const bf16*)(F.ws + WS_WG) + (size_t)(c * 8 + hd) * 256 * 128;
#pragma unroll
      for (int ks = 0; ks < 4; ++ks) { wa[ks] = *(const bf16x8*)(WG + (size_t)(w * 16 + r16) * 128 + ks * 32 + kq * 8); wx[ks] = *(const bf16x8*)(WG + (size_t)(128 + w * 16 + r16) * 128 + ks * 32 + kq * 8); } }
    float bra[4], brx[4], sp8[4];
#pragma unroll
    for (int i = 0; i < 4; ++i) { const int cg = hd * 128 + w * 16 + kq * 4 + i; bra[i] = F.b_rg_a()[c * 1024 + cg]; brx[i] = F.b_rg_x()[c * 1024 + cg]; sp8[i] = -8.0f * LOG2E * log1pf(expf(-F.lam()[c * 1024 + cg])); }
    const int rowS = b * T + sgm * 512;
    v2u xr[7];
#define LRU_LOADX(dst, rowc) do { _Pragma("unroll") for (int r = 0; r < 7; ++r) { const int rw = (rowc) + rq * 4 + r - 3; dst[r] = (rw >= b * T) ? *(const v2u*)(XBZ + (size_t)rw * 2048 + cg4) : (v2u){0u, 0u}; } } while (0)
    LRU_LOADX(xr, rowS);
    float Prun = 1.f, Hrun = 0.f;
#pragma nounroll
    for (int kk = 0; kk < 8; ++kk) {
        const int row0 = rowS + kk * 64;
        v2u xn[7];
        if (kk < 7) LRU_LOADX(xn, row0 + 64);
        LDS_BARRIER();
        {
            f32x4 x[7];
#pragma unroll
            for (int r = 0; r < 7; ++r) x[r] = (f32x4){bflo(xr[r].x), bfhi(xr[r].x), bflo(xr[r].y), bfhi(xr[r].y)};
#pragma unroll
            for (int q = 0; q < 4; ++q) { const int rr = rq * 4 + q; const f32x4 v = cbv + cw[0] * x[q] + cw[1] * x[q + 1] + cw[2] * x[q + 2] + cw[3] * x[q + 3];
                *(LAS f32x4*)(xf + rr * XL + cq * 4) = v; v2u o; o.x = pk2(v[0], v[1]); o.y = pk2(v[2], v[3]); *(LAS v2u*)(xc + rr * 136 + cq * 4) = o; }
        }
        LDS_BARRIER();
        {
            f32x4 acc[2][4];
#pragma unroll
            for (int i = 0; i < 2; ++i)
#pragma unroll
                for (int tt = 0; tt < 4; ++tt) acc[i][tt] = (f32x4){0.f, 0.f, 0.f, 0.f};
#pragma unroll
            for (int ks = 0; ks < 4; ++ks)
#pragma unroll
                for (int tt = 0; tt < 4; ++tt) { const bf16x8 bq = *(const LAS bf16x8*)(xc + (tt * 16 + r16) * 136 + ks * 32 + kq * 8); acc[0][tt] = mfma16(wa[ks], bq, acc[0][tt]); acc[1][tt] = mfma16(wx[ks], bq, acc[1][tt]); }
#pragma unroll
            for (int tt = 0; tt < 4; ++tt) { const int t = tt * 16 + r16; LAS f32x4* xp = (LAS f32x4*)(xf + t * XL + w * 16 + kq * 4); LAS f32x4* ap = (LAS f32x4*)(aa + t * XL + w * 16 + kq * 4);
                const f32x4 xv = *xp; f32x4 av4, bv4;
#pragma unroll
                for (int i = 0; i < 4; ++i) { const float rg = fsigmoid(acc[0][tt][i] + bra[i]), ig = fsigmoid(acc[1][tt][i] + brx[i]);
                    const float av = fexp2(rg * sp8[i]), mult = __builtin_amdgcn_sqrtf(fmaxf(1.0f - av * av, 0.f)); av4[i] = av; bv4[i] = mult * ig * xv[i]; }
                *ap = av4; *xp = bv4; }
        }
        LDS_BARRIER();
        float av[16], bv[16]; float P = 1.f, H = 0.f;
#pragma unroll
        for (int r = 0; r < 16; ++r) { av[r] = aa[(sg * 16 + r) * XL + ch]; bv[r] = xf[(sg * 16 + r) * XL + ch]; }
#pragma unroll
        for (int r = 0; r < 16; ++r) { H = av[r] * H + bv[r]; P *= av[r]; }
        seg[(sg * 128 + ch) * 2] = P; seg[(sg * 128 + ch) * 2 + 1] = H;
        LDS_BARRIER();
        float Ps = Prun, Hs = Hrun, Pe = Prun, He = Hrun;
#pragma unroll
        for (int s2 = 0; s2 < 4; ++s2) { const float p = seg[(s2 * 128 + ch) * 2], hq = seg[(s2 * 128 + ch) * 2 + 1]; He = p * He + hq; Pe *= p; if (s2 < sg) { Hs = p * Hs + hq; Ps *= p; } }
        if (kk < 7) {
            asm volatile("s_waitcnt vmcnt(0)" ::: "memory");
#pragma unroll
            for (int r = 0; r < 7; ++r) { xr[r] = xn[r]; asm volatile("" : "+v"(xr[r].x), "+v"(xr[r].y)); } }
        {
            unsigned* hp = HP + (size_t)(row0 + sg * 16) * 1024 + chg; float hh = Hs, pp = Ps;
#pragma unroll
            for (int r = 0; r < 16; ++r) { hh = av[r] * hh + bv[r]; pp *= av[r]; hp[(size_t)r * 1024] = pk2(hh, pp); }
        }
        Prun = Pe; Hrun = He;
    }
#undef LRU_LOADX
    if (sg == 0) { float* ls = (float*)(F.ws + WS_LSUM) + ((size_t)((b * 16 + sgm) * 1024) + chg) * 2; ls[0] = Prun; ls[1] = Hrun; }
}
__device__ __forceinline__ void lru_fix_task(Frame& F, int c, int b, int sgm, int e8) {
    const bf16* XBZ = (const bf16*)(F.ws + WS_PROJ); const unsigned* HP = (const unsigned*)(F.ws + WS_HP); bf16* YL = (bf16*)(F.ws + WS_ACT2);
    const int ch = F.tid * 2;
    float c0 = 0.f, c1 = 0.f;
    { f32x4 sm[15];
#pragma unroll
      for (int s2 = 0; s2 < 15; ++s2) sm[s2] = (s2 < sgm) ? *(const f32x4*)((const float*)(F.ws + WS_LSUM) + ((size_t)((b * 16 + s2) * 1024) + ch) * 2) : (f32x4){1.f, 0.f, 1.f, 0.f};
#pragma unroll
      for (int s2 = 0; s2 < 15; ++s2) { c0 = sm[s2][0] * c0 + sm[s2][1]; c1 = sm[s2][2] * c1 + sm[s2][3]; } }
    const int row0 = b * T + sgm * 512 + e8 * 64;
    float h0 = 0.f, h1 = 0.f;
    v2u hp[2][8]; unsigned zz[2][8]; const unsigned tid = (unsigned)F.tid & 511u;
#define FIX_LOAD(buf, rb_) do { _Pragma("unroll") for (int r = 0; r < 8; ++r) { const size_t row = (size_t)(row0 + (rb_) + r); hp[buf][r] = __builtin_nontemporal_load((const GAS v2u*)(HP + row * 1024) + tid); zz[buf][r] = __builtin_nontemporal_load((const GAS unsigned*)(XBZ + row * 2048 + 1024) + tid); } } while (0)
    FIX_LOAD(0, 0);
#pragma unroll
    for (int bi = 0; bi < 8; ++bi) {
        if (bi < 7) FIX_LOAD((bi + 1) & 1, (bi + 1) * 8);
        asm volatile("" ::: "memory");
#pragma unroll
        for (int r = 0; r < 8; ++r) { const v2u q = hp[bi & 1][r]; const unsigned z = zz[bi & 1][r]; h0 = bflo(q.x) + bfhi(q.x) * c0; h1 = bflo(q.y) + bfhi(q.y) * c1;
            ((GAS unsigned*)(YL + (size_t)(row0 + bi * 8 + r) * D))[tid] = pk2(h0 * fsilu(bflo(z)), h1 * fsilu(bfhi(z))); }
        asm volatile("" ::: "memory");
    }
#undef FIX_LOAD
    if (sgm == 15 && e8 == 7) { float* ho = F.out + O_HP + (size_t)(c * BATCH + b) * 1024 + ch; ho[0] = h0; ho[1] = h1; }
}
__device__ __forceinline__ void p_lru1(Frame& F, int c) {
    constexpr int NPT = BATCH * 8 * 16;
    for (int u = F.vcu; u < NPT; u += F.G) {
        __syncthreads(); relaunder(F);
        lru_seg_task(F, c, u >> 7, u & 7, (u >> 3) & 15);
    }
}
__device__ __forceinline__ void p_lru2(Frame& F, int c) {
    for (int u = F.vcu; u < BATCH * 16 * 8; u += F.G) { relaunder(F); lru_fix_task(F, c, u >> 7, (u >> 3) & 15, u & 7); }
}
template <int NT>
__device__ __forceinline__ void spiece_mma(f32x4 (&acc)[NT], const bf16* X  , const bf16* Wt  , int lane, size_t tstride = (size_t)16 * 1024  ) {
    const int r16 = lane & 15, kq = lane >> 4;
#pragma unroll
    for (int t = 0; t < NT; ++t) acc[t] = (f32x4){0.f, 0.f, 0.f, 0.f};
    const bf16* xp = X + (size_t)r16 * 1024 + kq * 8; const bf16* wp = Wt + (size_t)r16 * 1024 + kq * 8;
#pragma nounroll
    for (int kb = 0; kb < 32; kb += 8) {
        bf16x8 xb[8], wb[NT][8];
#pragma unroll
        for (int k = 0; k < 8; ++k) { xb[k] = *(const bf16x8*)(xp + (kb + k) * 32);
#pragma unroll
            for (int t = 0; t < NT; ++t) wb[t][k] = *(const bf16x8*)(wp + (size_t)t * tstride + (kb + k) * 32); }
#pragma unroll
        for (int k = 0; k < 8; ++k)
#pragma unroll
            for (int t = 0; t < NT; ++t) acc[t] = mfma16(wb[t][k], xb[k], acc[t]);
    }
}
__device__ __forceinline__ void spiece_res(Frame& F, const bf16* Wt) {
    const int lane = F.lane, w = F.wave, r16 = lane & 15, kq = lane >> 4;
    LAS float* red = (LAS float*)(F.lds + RING_OFF);
    for (int p = F.vcu; p < 256; p += F.G) {
        const int rg = p >> 3, cc = p & 7, r0 = MP + rg * 16, c0 = cc * 128 + w * 16;
        f32x4 acc[1]; spiece_mma<1>(acc, (const bf16*)(F.ws + WS_ACT2) + (size_t)r0 * 1024, Wt + (size_t)c0 * 1024, lane);
        const int row = r0 + r16, col = c0 + kq * 4;
        bf16* rp = (bf16*)(F.ws + WS_XG) + (size_t)row * 1024 + col; const v2u q = *(const v2u*)rp;
        const f32x4 v = acc[0] + (f32x4){bflo(q.x), bfhi(q.x), bflo(q.y), bfhi(q.y)};
        v2u xo; xo.x = pk2(v[0], v[1]); xo.y = pk2(v[2], v[3]); *(v2u*)rp = xo;
        float ss = (v[0] * v[0] + v[1] * v[1]) + (v[2] * v[2] + v[3] * v[3]);
        ss += __shfl_xor(ss, 16); ss += __shfl_xor(ss, 32);
        __syncthreads();
        if (kq == 0) red[w * 16 + r16] = ss;
        LDS_WAIT(); __syncthreads();
        if (F.tid < 16) { float s = 0.f;
#pragma unroll
            for (int ww = 0; ww < 8; ++ww) s += red[ww * 16 + F.tid];
            float* sq = (float*)(F.ws + WS_SSQ) + (size_t)(r0 + F.tid) * 16; sq[cc] = s; sq[8 + cc] = 0.f; }
    }
}
__device__ __forceinline__ void spiece_inc(Frame& F, const bf16* Wt, int L) {
    const int lane = F.lane, w = F.wave, r16 = lane & 15, kq = lane >> 4;
    for (int p = F.vcu; p < 256; p += F.G) {
        const int rg = p >> 3, cc = p & 7, r0 = MP + rg * 16, c0 = cc * 256 + w * 32;
        f32x4 acc[2]; spiece_mma<2>(acc, (const bf16*)(F.ws + WS_XG) + (size_t)r0 * 1024, Wt + (size_t)c0 * 1024, lane);
        const int row = r0 + r16; const float ri = pg8::row_rinv((const float*)(F.ws + WS_SSQ), row);
        const int s = (row - MP) >> 2, t = (row - MP) & 3;
#pragma unroll
        for (int tt = 0; tt < 2; ++tt) { const int col = c0 + tt * 16 + kq * 4; const f32x4 v = acc[tt] * ri;
            v2u xo; xo.x = pk2(v[0], v[1]); xo.y = pk2(v[2], v[3]);
            *(v2u*)((bf16*)(F.ws + WS_PROJ) + (size_t)row * 2048 + col) = xo;
            if (col < 1024 && t >= 1) *(f32x4*)(F.out + O_CVS + (((size_t)L * DEC_B + s) * 3 + (t - 1)) * 1024 + col) = v; }
    }
}
__device__ __forceinline__ void spiece_inc_lru(Frame& F, const bf16* Wt, int L) {
    const int lane = F.lane, w = F.wave, r16 = lane & 15, kq = lane >> 4, tid = F.tid;
    LAS float* xs = (LAS float*)(F.lds + RING_OFF);
    LAS float* zs = xs + 16 * 132;
    LAS float* aa = zs + 16 * 132;
    LAS bf16* xc = (LAS bf16*)(aa + 16 * 132);
    for (int p = F.vcu; p < 256; p += F.G) {
        const int rg = p >> 3, hd = p & 7, r0 = MP + rg * 16;
        const int ch = tid & 127, q = tid >> 7, chg = hd * 128 + ch, s = rg * 4 + q;
        const float cw0 = F.conv_w()[(L * 4 + 0) * 1024 + chg], cw1 = F.conv_w()[(L * 4 + 1) * 1024 + chg], cw2 = F.conv_w()[(L * 4 + 2) * 1024 + chg], cw3 = F.conv_w()[(L * 4 + 3) * 1024 + chg], cb = F.conv_b()[L * 1024 + chg];
        const float* cp = F.state_conv() + ((size_t)(L * DEC_B + s) * 3) * 1024 + chg; const float cs0 = cp[0], cs1 = cp[1024], cs2 = cp[2048];
        const float h0 = F.state_h()[((size_t)L * DEC_B + s) * 1024 + chg];
        bf16x8 wa[4], wx[4];
        { const bf16* WG = (const bf16*)(F.ws + WS_WG) + (size_t)(L * 8 + hd) * 256 * 128;
#pragma unroll
          for (int ks = 0; ks < 4; ++ks) { wa[ks] = *(const bf16x8*)(WG + (size_t)(w * 16 + r16) * 128 + ks * 32 + kq * 8); wx[ks] = *(const bf16x8*)(WG + (size_t)(128 + w * 16 + r16) * 128 + ks * 32 + kq * 8); } }
        float bra[4], brx[4], sp8[4];
#pragma unroll
        for (int i = 0; i < 4; ++i) { const int cg = hd * 128 + w * 16 + kq * 4 + i; bra[i] = F.b_rg_a()[L * 1024 + cg]; brx[i] = F.b_rg_x()[L * 1024 + cg]; sp8[i] = -8.0f * LOG2E * log1pf(expf(-F.lam()[L * 1024 + cg])); }
        f32x4 acc[2]; spiece_mma<2>(acc, (const bf16*)(F.ws + WS_XG) + (size_t)r0 * 1024, Wt + (size_t)(hd * 128 + w * 16) * 1024, lane, (size_t)1024 * 1024);
        {
            const int row = r0 + r16; const float ri = pg8::row_rinv((const float*)(F.ws + WS_SSQ), row);
            const f32x4 vx = acc[0] * ri, vz = acc[1] * ri; const int t = r16 & 3, sq = rg * 4 + (r16 >> 2), col = hd * 128 + w * 16 + kq * 4;
            if (t >= 1) *(f32x4*)(F.out + O_CVS + (((size_t)L * DEC_B + sq) * 3 + (t - 1)) * 1024 + col) = vx;
            __syncthreads();
            *(LAS f32x4*)(xs + r16 * 132 + w * 16 + kq * 4) = vx; *(LAS f32x4*)(zs + r16 * 132 + w * 16 + kq * 4) = vz;
        }
        LDS_WAIT(); __syncthreads();
        {
            const float x0 = xs[(q * 4 + 0) * 132 + ch], x1 = xs[(q * 4 + 1) * 132 + ch], x2 = xs[(q * 4 + 2) * 132 + ch], x3 = xs[(q * 4 + 3) * 132 + ch];
            const float v0 = cb + cw0 * cs0 + cw1 * cs1 + cw2 * cs2 + cw3 * x0, v1 = cb + cw0 * cs1 + cw1 * cs2 + cw2 * x0 + cw3 * x1;
            const float v2 = cb + cw0 * cs2 + cw1 * x0 + cw2 * x1 + cw3 * x2, v3 = cb + cw0 * x0 + cw1 * x1 + cw2 * x2 + cw3 * x3;
            xs[(q * 4 + 0) * 132 + ch] = v0; xs[(q * 4 + 1) * 132 + ch] = v1; xs[(q * 4 + 2) * 132 + ch] = v2; xs[(q * 4 + 3) * 132 + ch] = v3;
            xc[(q * 4 + 0) * 136 + ch] = (bf16)f2bf(v0); xc[(q * 4 + 1) * 136 + ch] = (bf16)f2bf(v1); xc[(q * 4 + 2) * 136 + ch] = (bf16)f2bf(v2); xc[(q * 4 + 3) * 136 + ch] = (bf16)f2bf(v3);
        }
        LDS_WAIT(); __syncthreads();
        {
            f32x4 ga = {0.f, 0.f, 0.f, 0.f}, gx = {0.f, 0.f, 0.f, 0.f};
#pragma unroll
            for (int ks = 0; ks < 4; ++ks) { const bf16x8 bq = *(const LAS bf16x8*)(xc + r16 * 136 + ks * 32 + kq * 8); ga = mfma16(wa[ks], bq, ga); gx = mfma16(wx[ks], bq, gx); }
#pragma unroll
            for (int i = 0; i < 4; ++i) { const int cl = w * 16 + kq * 4 + i;
                const float rgv = fsigmoid(ga[i] + bra[i]), ig = fsigmoid(gx[i] + brx[i]);
                const float av = fexp2(rgv * sp8[i]), mult = __builtin_amdgcn_sqrtf(fmaxf(1.0f - av * av, 0.f));
                const float xv = xs[r16 * 132 + cl]; aa[r16 * 132 + cl] = av; xs[r16 * 132 + cl] = mult * ig * xv; }
        }
        LDS_WAIT(); __syncthreads();
        {
            bf16* YL = (bf16*)(F.ws + WS_ACT2); float hh = h0;
#pragma unroll
            for (int t = 0; t < 4; ++t) { const int rr = q * 4 + t; hh = aa[rr * 132 + ch] * hh + xs[rr * 132 + ch];
                YL[(size_t)(r0 + rr) * D + chg] = (bf16)f2bf(hh * fsilu(zs[rr * 132 + ch])); }
            F.out[O_HS + ((size_t)L * DEC_B + s) * 1024 + chg] = hh;
        }
    }
}
#ifndef PROBE_DUP
#define PROBE_DUP 0
#endif
#ifndef MK_MULTI
#define MK_MULTI 0
#endif
constexpr int N_PHASES = 18;
__global__ void __launch_bounds__(NWAVES * 64, 2) hybrid_fwd(Args args) {
    extern __shared__ __attribute__((aligned(16))) unsigned char lds[];
    Frame F;
    F.lds = (LAS unsigned char*)lds;
    F.MISC = (volatile LAS unsigned*)(F.lds + MISC_OFF);
    F.tid = threadIdx.x; F.lane = F.tid & 63; F.wave = __builtin_amdgcn_readfirstlane(F.tid >> 6);
    F.G = gridDim.x; { const int bx = blockIdx.x; F.vcu = (F.G % 8 == 0) ? (bx % 8) * (F.G / 8) + bx / 8 : bx; }
    F.ws = args.ws; F.out = args.out; F.ctl = (gu32*)(args.ws + WS_CTL);
    for (int u = F.tid; u < (LDS_BYTES - LDSCTL_OFF) / 4; u += NWAVES * 64) ((LAS unsigned*)(F.lds + LDSCTL_OFF))[u] = 0u;
    __syncthreads();
    if (F.tid < 29) { const unsigned long long p = (unsigned long long)args.in[F.tid]; LAS unsigned* t = (LAS unsigned*)(F.lds + PTR_OFF) + 2 * F.tid; t[0] = (unsigned)p; t[1] = (unsigned)(p >> 32); }
    __syncthreads();
    XcdBarrier bar; bar.bar = (unsigned*)(F.ctl + CW_BAR); bar.x = 0; bar.st = nullptr; bar.w0 = F.wave == 0;
    if (args.use_bar) bar = xcd_barrier_post((unsigned*)(F.ctl + CW_BAR), F.MISC + 8, F.wave == 0);
    const int lo = args.ph_lo, hi = args.ph_hi; int bid_l = blockIdx.x;
    const int late_rem = ((M / 256) * (NPA / 256)) % (int)gridDim.x; const bool late = late_rem != 0;
#define IN(k) (lo <= (k) && (k) < hi)
#define RELAUNDER() do { int t_ = F.wave * 64 + lane_id(); asm volatile("" : "+v"(t_)); F.tid = t_; F.lane = t_ & 63; \
        unsigned long long w_ = (unsigned long long)args.ws, o_ = (unsigned long long)args.out; asm volatile("" : "+s"(w_), "+s"(o_)); F.ws = (unsigned char*)(GAS unsigned char*)w_; F.out = (float*)(GAS float*)o_; F.ctl = (gu32*)(F.ws + WS_CTL); int b_ = blockIdx.x, g_ = gridDim.x; asm volatile("" : "+s"(b_), "+s"(g_)); bid_l = b_; F.G = g_; } while (0)
#define SEAM(k) do { if (IN(k) && IN((k) + 1)) { xcd_barrier(bar); if (PROBE_DUP & 128) xcd_barrier(bar); } } while (0)
#define WSP(T, off) ((T*)(F.ws + (off)))

    static_assert(pg8::PW_KSLC == WS_KSLC && pg8::PW_VSLC == WS_VSLC && pg8::PW_KWIN == WS_KWIN && pg8::PW_VWIN == WS_VWIN && pg8::PW_MEAN == WS_MEAN && RING_BYTES + pg8::RINV_OFF + 1024 <= SCRATCH_BYTES, "epilogue map");
    static_assert(pg8::PO_NSAP == O_NSAP && pg8::PO_NSAS == O_NSAS && pg8::PO_WINP == O_WINP && pg8::PO_WINS == O_WINS && pg8::PO_CVP == O_CVP && pg8::PO_CVS == O_CVS, "output map");
    if (IN(0)) {
#ifndef NO_P0
 for (int rep = 0; rep < ((PROBE_DUP & 64) ? 2 : 1); ++rep) { if (rep) xcd_barrier(bar); RELAUNDER(); p0_prologue(F, !late); }
#endif
 } SEAM(0);
    for (int L = 0; L < 2; ++L) {
        const int pb = 1 + 8 * L;
        if (IN(pb + 0)) {
            RELAUNDER();
            pg8::Gemm g{WSP(bf16, WS_XG), (const bf16*)(F.ws + WS_WINA) + (size_t)L * NPA * D, M, NPA, D}; pg8::StaticOrder S; S.init(M, NPA, F.G, bid_l);
            pg8::EpiInA E{WSP(bf16, WS_PROJ), WSP(float, WS_SSQ), F.out, L, F.ws, F.lds + RING_OFF + RING_BYTES};
#ifndef NO_GEMM
            for (int rep = 0; rep < ((PROBE_DUP & 4) ? 2 : 1); ++rep) { if (rep) xcd_barrier(bar); pg8::gemm_phase<pg8::EpiInA, pg8::StaticOrder, true, true>(F.lds + RING_OFF, g, S, E, F.wave); }
#endif
            if (L == 0 && late && bid_l >= late_rem) { __syncthreads(); RELAUNDER(); p0_late(F, bid_l - late_rem, F.G - late_rem); }
        } SEAM(pb + 0);
        if (IN(pb + 1)) {
#ifndef NO_PREP
 for (int rep = 0; rep < ((PROBE_DUP & 8) ? 2 : 1); ++rep) { if (rep) xcd_barrier(bar); RELAUNDER(); p_prep(F, L); }
#endif
 } SEAM(pb + 1);
        if (IN(pb + 2)) {
#ifndef NO_ATTN
 for (int rep = 0; rep < ((PROBE_DUP & 1) ? 2 : 1); ++rep) { if (rep) xcd_barrier(bar); RELAUNDER(); p_attn(F, L); }
#endif
 } SEAM(pb + 2);
        if (IN(pb + 3)) {
            RELAUNDER();
            pg8::Gemm g{WSP(bf16, WS_ACT2), (const bf16*)(F.ws + WS_WOUTA) + (size_t)L * D * D, MP, D, D}; pg8::StaticOrder S; S.init(MP, D, F.G, bid_l);
            pg8::EpiRes E{WSP(bf16, WS_XG), WSP(float, WS_SSQ)};
#ifndef NO_GEMM
            pg8::gemm_phase<pg8::EpiRes, pg8::StaticOrder, true, true>(F.lds + RING_OFF, g, S, E, F.wave);
            RELAUNDER(); spiece_res(F, (const bf16*)(F.ws + WS_WOUTA) + (size_t)L * D * D);
#endif
        } SEAM(pb + 3);
        if (IN(pb + 4)) {
            RELAUNDER();
            pg8::Gemm g{WSP(bf16, WS_XG), (const bf16*)(F.ws + WS_WINC) + (size_t)L * 2048 * D, MP, 2048, D}; pg8::StaticOrder S; S.init(MP, 2048, F.G, bid_l);
            pg8::EpiInC E{WSP(bf16, WS_PROJ), WSP(float, WS_SSQ), F.out, L, F.lds + RING_OFF + RING_BYTES};
#ifndef NO_GEMM
            for (int rep = 0; rep < ((PROBE_DUP & 16) ? 2 : 1); ++rep) { if (rep) xcd_barrier(bar); pg8::gemm_phase<pg8::EpiInC, pg8::StaticOrder, true, true>(F.lds + RING_OFF, g, S, E, F.wave); }
            RELAUNDER(); spiece_inc_lru(F, (const bf16*)(F.ws + WS_WINC) + (size_t)L * 2048 * D, L);
#endif
        } SEAM(pb + 4);
        if (IN(pb + 5)) { for (int rep = 0; rep < ((PROBE_DUP & 32) ? 2 : 1); ++rep) { if (rep) xcd_barrier(bar); RELAUNDER(); p_lru1(F, L); } } SEAM(pb + 5);
        if (IN(pb + 6)) { for (int rep = 0; rep < ((PROBE_DUP & 2) ? 2 : 1); ++rep) { if (rep) xcd_barrier(bar); RELAUNDER(); p_lru2(F, L); } } SEAM(pb + 6);
        if (IN(pb + 7)) {
            RELAUNDER();
            pg8::Gemm g{WSP(bf16, WS_ACT2), (const bf16*)(F.ws + WS_WOUTC) + (size_t)L * D * D, MP, D, D}; pg8::StaticOrder S; S.init(MP, D, F.G, bid_l);
            pg8::EpiRes E{WSP(bf16, WS_XG), WSP(float, WS_SSQ)};
#ifndef NO_GEMM
            pg8::gemm_phase<pg8::EpiRes, pg8::StaticOrder, true, true>(F.lds + RING_OFF, g, S, E, F.wave);
            RELAUNDER(); spiece_res(F, (const bf16*)(F.ws + WS_WOUTC) + (size_t)L * D * D);
#endif
        } SEAM(pb + 7);
    }
    if (IN(17)) {
#ifndef NO_FINAL
 RELAUNDER(); p_final(F);
#endif
 }
#undef IN
#undef SEAM
}

extern "C" void kernel_launch(void* const* d_in, const int* in_sizes, int n_in, void* d_out, int out_size, void* d_ws, size_t ws_size, hipStream_t stream) {
    static int grid = 0;
    if (grid == 0) {
        if (n_in != 29 || (size_t)out_size != O_END || ws_size < WS_END) { fprintf(stderr, "kernel_launch: unexpected shapes: n_in %d out %d ws %zu\n", n_in, out_size, ws_size); grid = -1; return; }
        int dev = 0, cus = 0, per_cu = 0;
        if (hipGetDevice(&dev) != hipSuccess || hipDeviceGetAttribute(&cus, hipDeviceAttributeMultiprocessorCount, dev) != hipSuccess) { grid = -1; return; }
        if (hipFuncSetAttribute((const void*)hybrid_fwd, hipFuncAttributeMaxDynamicSharedMemorySize, LDS_BYTES) != hipSuccess) { fprintf(stderr, "kernel_launch: hipFuncSetAttribute failed\n"); grid = -1; return; }
        if (hipOccupancyMaxActiveBlocksPerMultiprocessor(&per_cu, (const void*)hybrid_fwd, NWAVES * 64, LDS_BYTES) != hipSuccess || per_cu < 1)
            fprintf(stderr, "kernel_launch: note: occupancy query reports %d workgroups per CU\n", per_cu);
        (void)hipGetLastError();
        grid = cus;
    }
    if (grid < 0) return;
    if (hipMemsetAsync((char*)d_ws + WS_CTL, 0, CTL_ZERO_BYTES, stream) != hipSuccess) return;
    Args a{};
    for (int i = 0; i < 29; ++i) a.in[i] = d_in[i];
    a.out = (float*)d_out; a.ws = (unsigned char*)d_ws; a.pad = 0;
#if MK_MULTI
    for (int p = 0; p < N_PHASES; ++p) { a.ph_lo = p; a.ph_hi = p + 1; a.use_bar = 0; hipLaunchKernelGGL(hybrid_fwd, dim3(grid), dim3(NWAVES * 64), LDS_BYTES, stream, a); }
#else
    a.ph_lo = 0; a.ph_hi = N_PHASES; a.use_bar = 1;
    hipLaunchKernelGGL(hybrid_fwd, dim3(grid), dim3(NWAVES * 64), LDS_BYTES, stream, a);
#endif
}
```

```cpp
#include <hip/hip_runtime.h>
#include <cstdio>
#include <cstdint>
namespace pg8 {
#define PG8_LAS __attribute__((address_space(3)))
typedef unsigned short bf16_t;
typedef short bf16x8 __attribute__((ext_vector_type(8)));
typedef float f32x4 __attribute__((ext_vector_type(4)));
typedef unsigned u32x4 __attribute__((ext_vector_type(4)));
constexpr int BM = 256, BK = 64, HALF = 128, HTB = HALF * BK * 2  , STAGE_BYTES = 8 * HTB, NXCD = 8, WGM = 8;

__host__ __device__ __forceinline__ int lds_byte(int r, int c) { const int st = (r >> 4) * 2 + (c >> 5), rr = r & 15, cc = c & 31, ob = rr * 64 + cc * 2; return st * 1024 + (ob ^ (((ob >> 9) & 1) << 5)); }
__host__ __device__ __forceinline__ void stage_rc(int b, int& R, int& C) { const int st = b / 1024, sb = b % 1024, swz = sb ^ (((sb >> 9) & 1) << 5); R = (st >> 1) * 16 + swz / 64; C = (st & 1) * 32 + (swz % 64) / 2; }
__host__ __device__ __forceinline__ int perm32(int rho) { const int n = rho >> 4, i = rho & 15; return 8 * (i >> 2) + 4 * n + (i & 3); }

struct Unit { int pm, pn; };
struct Gemm { const bf16_t* A; const bf16_t* Bt; int M, N, K; };

struct StaticOrder {
    int nM, nN, nwg, G, c;
    __host__ __device__ void init(int M, int N, int G_, int c_) { nM = M / BM; nN = N / BM; nwg = nM * nN; G = G_; c = c_; }
    __host__ __device__ bool next(int i, Unit& u) const {
        const long L = (long)i * G + c; if (L >= nwg) return false;
        int wgid = (int)L; { const int q = nwg / NXCD, r = nwg % NXCD, xcd = wgid % NXCD, off = wgid / NXCD; wgid = (xcd < r ? xcd * (q + 1) : r * (q + 1) + (xcd - r) * q) + off; }
        const int nig = WGM * nN, gid = wgid / nig, fm = gid * WGM, gsz = (nM - fm) < WGM ? (nM - fm) : WGM;
        u.pm = fm + ((wgid % nig) % gsz); u.pn = (wgid % nig) / gsz; return true;
    }
    __device__ __forceinline__ void a_ready(const Unit&) const {}
    __device__ __forceinline__ void done(const Unit&) const {}
};

__device__ __forceinline__ unsigned cvt_pk_bf16(float lo, float hi) { unsigned r; asm volatile("v_cvt_pk_bf16_f32 %0, %1, %2" : "=v"(r) : "v"(lo), "v"(hi)); return r; }
typedef float f32x2 __attribute__((ext_vector_type(2)));
constexpr int MPROMPT = 16384;
constexpr size_t PO_YP = 0, PO_YS = PO_YP + (size_t)16384 * 1024, PO_NSAP = PO_YS + (size_t)512 * 1024, PO_NSAS = PO_NSAP + (size_t)2 * 16384 * 512, PO_WINP = PO_NSAS + (size_t)2 * 512 * 512,
                 PO_WINS = PO_WINP + (size_t)2 * 2 * 512 * 256, PO_GV = PO_WINS + (size_t)2 * 512 * 256, PO_HP = PO_GV + (size_t)2 * 512 * 512, PO_HS = PO_HP + (size_t)2 * 2 * 1024,
                 PO_CVP = PO_HS + (size_t)2 * 128 * 1024, PO_CVS = PO_CVP + (size_t)2 * 2 * 3 * 1024;
__device__ __forceinline__ float row_rinv(const float* ssq, int row) {
    const f32x4* p = (const f32x4*)(ssq + (size_t)row * 16);
    const f32x4 a = p[0], b = p[1], c = p[2], d = p[3];
    const float s = ((a[0] + a[1]) + (a[2] + a[3])) + ((b[0] + b[1]) + (b[2] + b[3])) + ((c[0] + c[1]) + (c[2] + c[3])) + ((d[0] + d[1]) + (d[2] + d[3]));
    return rsqrtf(s * (1.0f / 1024.0f) + 1e-6f);
}
constexpr size_t PW_KSLC = (size_t)44 << 20, PW_VSLC = (size_t)48 << 20, PW_KWIN = (size_t)52 << 20, PW_VWIN = (size_t)56 << 20, PW_MEAN = (size_t)132 << 20;
constexpr int VT_WAVE = 2560, VT_LD = 40;
template <int CTRL> __device__ __forceinline__ float dppf(float x) { return __builtin_bit_cast(float, __builtin_amdgcn_mov_dpp(__builtin_bit_cast(int, x), CTRL, 0xf, 0xf, true)); }
__device__ __forceinline__ float row16_sum(float x) { x += dppf<0xB1>(x); x += dppf<0x4E>(x); x += dppf<0x124>(x); x += dppf<0x128>(x); return x; }
constexpr int RINV_OFF = 8 * VT_WAVE;
__device__ __forceinline__ void unit_rinv(float (&ris)[2][4], const float* ssq, __attribute__((address_space(3))) unsigned char* vt, const Unit& u, int wr, int wc, int fr, int fq) {
    typedef __attribute__((address_space(3))) float lds_f32;
    lds_f32* rl = (lds_f32*)(vt + RINV_OFF) + wr * 128;
    const int lane = fr + 16 * fq;
    if (lane < 32) { const int q = wc * 32 + lane; rl[q] = row_rinv(ssq, u.pm * BM + (q >> 6) * HALF + wr * 64 + (q & 63)); }
    asm volatile("s_waitcnt lgkmcnt(0)" ::: "memory"); __builtin_amdgcn_s_barrier(); asm volatile("" ::: "memory");
#pragma unroll
    for (int ai = 0; ai < 2; ++ai)
#pragma unroll
        for (int m = 0; m < 4; ++m) ris[ai][m] = rl[ai * 64 + m * 16 + fr];
}
struct EpiInA {
    static constexpr bool PERM = true, AFTER_DRAIN = false;
    bf16_t* proj; const float* ssq; float* out; int L;
    unsigned char* ws; __attribute__((address_space(3))) unsigned char* vt;
    __device__ __forceinline__ void operator()(const f32x4 (&acc)[2][2][4][2], const Unit& u, int wr, int wc, int fr, int fq) const {
        typedef __attribute__((address_space(3))) unsigned short lds_u16; typedef __attribute__((address_space(3))) u32x4 lds_u32x4;
        const int row0 = u.pm * BM + wr * 64 + fr, colt = u.pn * BM + wc * 32 + 8 * fq;
        const bool pr = u.pm < MPROMPT / BM, kvt = pr && (u.pn == 3 || u.pn == 4), cmt = pr && u.pn == 2, keep = !(pr && u.pn >= 2 && u.pn <= 4);
        const int g = wc >> 1, lane = fr + 16 * fq;
        float risu[2][4]; unit_rinv(risu, ssq, vt, u, wr, wc, fr, fq);
#pragma unroll
        for (int ai = 0; ai < 2; ++ai) {
            const int rb = u.pm * BM + ai * HALF + wr * 64, bb = rb >> 13, blk = (rb >> 6) & 127;
            f32x4 cs[2][2]; float ris[4];
#pragma unroll
            for (int bj = 0; bj < 2; ++bj) { cs[bj][0] = (f32x4){0.f, 0.f, 0.f, 0.f}; cs[bj][1] = (f32x4){0.f, 0.f, 0.f, 0.f}; }
#pragma unroll
            for (int m = 0; m < 4; ++m) {
                const int row = row0 + ai * HALF + m * 16; const float ri = risu[ai][m]; ris[m] = ri;
                bf16_t* rowp = proj + (size_t)row * 3584 + colt;
#pragma unroll
                for (int bj = 0; bj < 2; ++bj) {
                    const f32x4 v0 = acc[ai][bj][m][0] * ri, v1 = acc[ai][bj][m][1] * ri;
                    u32x4 w; w.x = cvt_pk_bf16(v0[0], v0[1]); w.y = cvt_pk_bf16(v0[2], v0[3]); w.z = cvt_pk_bf16(v1[0], v1[1]); w.w = cvt_pk_bf16(v1[2], v1[3]);
                    if (keep) *(u32x4*)(rowp + bj * HALF) = w;
                    if (u.pn == 2 || u.pn == 3) {
                        const int kc = (u.pn - 2) * 256 + bj * HALF + wc * 32 + 8 * fq;
                        float* o = out + ((row < MPROMPT) ? PO_NSAP + ((size_t)L * MPROMPT + row) * 512 + kc : PO_NSAS + ((size_t)L * 512 + (row - MPROMPT)) * 512 + kc);
                        __builtin_nontemporal_store(v0, (f32x4*)o); __builtin_nontemporal_store(v1, (f32x4*)(o + 4));
                    } else if (u.pn == 4) {
                        const int kc = bj * HALF + wc * 32 + 8 * fq;
                        if (row < MPROMPT) { const int b = row >> 13, t = row & 8191;
                            if (t >= 8192 - 512) { float* o = out + PO_WINP + (((size_t)L * 2 + b) * 512 + (t - (8192 - 512))) * 256 + kc; __builtin_nontemporal_store(v0, (f32x4*)o); __builtin_nontemporal_store(v1, (f32x4*)(o + 4)); } }
                        else { float* o = out + PO_WINS + ((size_t)L * 512 + (row - MPROMPT)) * 256 + kc; __builtin_nontemporal_store(v0, (f32x4*)o); __builtin_nontemporal_store(v1, (f32x4*)(o + 4)); }
                    }
                    if (kvt && bj == 0)
                        *((u32x4*)(ws + (u.pn == 3 ? PW_KSLC : PW_KWIN)) + ((size_t)((bb * 2 + g) * 128 + blk)) * 512 + (m * 2 + (wc & 1)) * 64 + lane) = w;
                    if (cmt) { cs[bj][0] += v0; cs[bj][1] += v1; }
                }
            }
            if (cmt) {
#pragma unroll
                for (int bj = 0; bj < 2; ++bj) {
#pragma unroll
                    for (int n = 0; n < 2; ++n)
#pragma unroll
                        for (int i = 0; i < 4; ++i) cs[bj][n][i] = row16_sum(cs[bj][n][i]) * (1.0f / 64.0f);
                    if (fr == 0) { float* mp = (float*)(ws + PW_MEAN) + ((((size_t)(bb * 128 + blk) * 2 + bj) * 2 + g) * 64 + (wc & 1) * 32 + 8 * fq); *(f32x4*)mp = cs[bj][0]; *(f32x4*)(mp + 4) = cs[bj][1]; }
                }
            }
            if (kvt) {
                lds_u16* tile = (lds_u16*)(vt + (wr * 4 + wc) * VT_WAVE);
                u32x4* dstv = (u32x4*)(ws + (u.pn == 3 ? PW_VSLC : PW_VWIN)) + ((size_t)((bb * 2 + g) * 128 + blk)) * 512;
#pragma unroll
                for (int ks2 = 0; ks2 < 2; ++ks2) {
#pragma unroll
                    for (int mm = 0; mm < 2; ++mm) { const int m = 2 * ks2 + mm; const f32x4 v0 = acc[ai][1][m][0] * ris[m], v1 = acc[ai][1][m][1] * ris[m];
                        u32x4 w; w.x = cvt_pk_bf16(v0[0], v0[1]); w.y = cvt_pk_bf16(v0[2], v0[3]); w.z = cvt_pk_bf16(v1[0], v1[1]); w.w = cvt_pk_bf16(v1[2], v1[3]);
                        *(lds_u32x4*)(tile + (mm * 16 + fr) * VT_LD + 8 * fq) = w; }
                    asm volatile("s_waitcnt lgkmcnt(0)" ::: "memory");
#pragma unroll
                    for (int dtl = 0; dtl < 2; ++dtl) { unsigned short v[8];
#pragma unroll
                        for (int e = 0; e < 8; ++e) v[e] = tile[((e >> 2) * 16 + fq * 4 + (e & 3)) * VT_LD + dtl * 16 + fr];
                        u32x4 o; o.x = v[0] | ((unsigned)v[1] << 16); o.y = v[2] | ((unsigned)v[3] << 16); o.z = v[4] | ((unsigned)v[5] << 16); o.w = v[6] | ((unsigned)v[7] << 16);
                        dstv[((2 * (wc & 1) + dtl) * 2 + ks2) * 64 + lane] = o; }
                    asm volatile("s_waitcnt lgkmcnt(0)" ::: "memory");
                }
            }
        }
    }
};
struct EpiInC {
    static constexpr bool PERM = true, AFTER_DRAIN = false;
    bf16_t* xbz; const float* ssq; float* out; int L; __attribute__((address_space(3))) unsigned char* vt;
    __device__ __forceinline__ void operator()(const f32x4 (&acc)[2][2][4][2], const Unit& u, int wr, int wc, int fr, int fq) const {
        const int row0 = u.pm * BM + wr * 64 + fr, colt = u.pn * BM + wc * 32 + 8 * fq;
        float risu[2][4]; unit_rinv(risu, ssq, vt, u, wr, wc, fr, fq);
#pragma unroll
        for (int ai = 0; ai < 2; ++ai)
#pragma unroll
            for (int m = 0; m < 4; ++m) {
                const int row = row0 + ai * HALF + m * 16; const float ri = risu[ai][m];
                bf16_t* rowp = xbz + (size_t)row * 2048 + colt;
                float* o = nullptr;
                if (u.pn < 4) {
                    if (row < MPROMPT) { const int b = row >> 13, t = row & 8191; if (t >= 8192 - 3) o = out + PO_CVP + (((size_t)L * 2 + b) * 3 + (t - (8192 - 3))) * 1024 + colt; }
                    else { const int s = (row - MPROMPT) >> 2, t = (row - MPROMPT) & 3; if (t >= 1) o = out + PO_CVS + (((size_t)L * 128 + s) * 3 + (t - 1)) * 1024 + colt; }
                }
#pragma unroll
                for (int bj = 0; bj < 2; ++bj) {
                    const f32x4 v0 = acc[ai][bj][m][0] * ri, v1 = acc[ai][bj][m][1] * ri;
                    u32x4 w; w.x = cvt_pk_bf16(v0[0], v0[1]); w.y = cvt_pk_bf16(v0[2], v0[3]); w.z = cvt_pk_bf16(v1[0], v1[1]); w.w = cvt_pk_bf16(v1[2], v1[3]);
                    *(u32x4*)(rowp + bj * HALF) = w;
                    if (o) { *(f32x4*)(o + bj * HALF) = v0; *(f32x4*)(o + bj * HALF + 4) = v1; }
                }
            }
    }
};
struct EpiRes {
    static constexpr bool PERM = true, AFTER_DRAIN = false;
    bf16_t* r; float* ssq;
    __device__ __forceinline__ void operator()(const f32x4 (&acc)[2][2][4][2], const Unit& u, int wr, int wc, int fr, int fq) const {
        typedef __attribute__((address_space(1))) unsigned char gbyte; typedef __attribute__((address_space(1))) u32x4 g_u32x4;
        const int row0 = u.pm * BM + wr * 64 + fr, colt = u.pn * BM + wc * 32 + 8 * fq;
        gbyte* rb = (gbyte*)(unsigned long long)r;
        const unsigned off0 = ((unsigned)row0 * 1024u + (unsigned)colt) * 2u;
        u32x4 qr[2][4][2];
#pragma unroll
        for (int ai = 0; ai < 2; ++ai)
#pragma unroll
            for (int m = 0; m < 4; ++m)
#pragma unroll
                for (int bj = 0; bj < 2; ++bj) qr[ai][m][bj] = *(const g_u32x4*)(rb + (off0 + (unsigned)((ai * HALF + m * 16) * 2048 + bj * HALF * 2)));
#pragma unroll
        for (int ai = 0; ai < 2; ++ai)
#pragma unroll
            for (int m = 0; m < 4; ++m) {
                const int row = row0 + ai * HALF + m * 16;
                float ss = 0.f;
#pragma unroll
                for (int bj = 0; bj < 2; ++bj) {
                    const u32x4 q = qr[ai][m][bj];
                    const f32x4 r0 = {__builtin_bit_cast(float, q.x << 16), __builtin_bit_cast(float, q.x & 0xffff0000u), __builtin_bit_cast(float, q.y << 16), __builtin_bit_cast(float, q.y & 0xffff0000u)};
                    const f32x4 r1 = {__builtin_bit_cast(float, q.z << 16), __builtin_bit_cast(float, q.z & 0xffff0000u), __builtin_bit_cast(float, q.w << 16), __builtin_bit_cast(float, q.w & 0xffff0000u)};
                    const f32x4 v0 = acc[ai][bj][m][0] + r0, v1 = acc[ai][bj][m][1] + r1;
                    ss += ((v0[0] * v0[0] + v0[1] * v0[1]) + (v0[2] * v0[2] + v0[3] * v0[3])) + ((v1[0] * v1[0] + v1[1] * v1[1]) + (v1[2] * v1[2] + v1[3] * v1[3]));
                    u32x4 w; w.x = cvt_pk_bf16(v0[0], v0[1]); w.y = cvt_pk_bf16(v0[2], v0[3]); w.z = cvt_pk_bf16(v1[0], v1[1]); w.w = cvt_pk_bf16(v1[2], v1[3]);
                    *(g_u32x4*)(rb + (off0 + (unsigned)((ai * HALF + m * 16) * 2048 + bj * HALF * 2))) = w;
                }
                ss += __shfl_xor(ss, 16); ss += __shfl_xor(ss, 32);
                if (fq == 0) ssq[(size_t)row * 16 + u.pn * 4 + wc] = ss;
            }
    }
};
template <class Epi, class Sched, bool ALIGN_EPI = false, bool SP2 = false>
__device__ __forceinline__ void gemm_phase(PG8_LAS unsigned char* lds, const Gemm g, const Sched& S, const Epi& E, int wave_in  ) {
    int tid_; asm volatile("v_mbcnt_lo_u32_b32 %0, -1, 0\n\tv_mbcnt_hi_u32_b32 %0, -1, %0" : "=v"(tid_)); tid_ += wave_in * 64;
    const int tid = tid_, wid = __builtin_amdgcn_readfirstlane(tid >> 6), lane = tid & 63, wr = wid >> 2, wc = wid & 3, fr = lane & 15, fq = lane >> 4;
    const int K = g.K, nt = K / BK;
    unsigned voffA[2], voffB[2];
#pragma unroll
    for (int i = 0; i < 2; ++i) { int R, C; stage_rc(tid * 16 + i * 8192, R, C); const int Rb = Epi::PERM ? ((R & ~31) + perm32(R & 31)) : R;
        voffA[i] = (unsigned)(R * K + C) * 2u; voffB[i] = (unsigned)(Rb * K + C) * 2u; }
    const size_t kstep = (size_t)(BK * 2);
    const size_t hstep = (size_t)HALF * K * 2;
    const size_t tstep = 2 * hstep;
    const unsigned ldsw = (unsigned)wid * 1024u;
    const int aoff = lds_byte(wr * 64 + fr, fq * 8), boff = lds_byte(wc * 32 + fr, fq * 8);
#define PG8_SA(b, h) (((b) * 2 + (h)) * HTB)
#define PG8_SB(b, h) ((4 + (b) * 2 + (h)) * HTB)
#define PG8_STAGE(bufoff, gbase, voff) do { _Pragma("unroll") for (int _i = 0; _i < 2; ++_i) \
        __builtin_amdgcn_global_load_lds((const unsigned*)((const char*)(gbase) + (voff)[_i]), (PG8_LAS unsigned*)(lds + (bufoff) + ldsw + _i * 8192), 16, 0, 0); } while (0)
#define PG8_LDA(dst, b, h) do { _Pragma("unroll") for (int m = 0; m < 4; ++m) _Pragma("unroll") for (int k = 0; k < 2; ++k) dst[m][k] = *(const PG8_LAS bf16x8*)(lds + PG8_SA(b, h) + aoff + m * 2048 + k * 1024); } while (0)
#define PG8_LDB(dst, b, h) do { _Pragma("unroll") for (int n = 0; n < 2; ++n) _Pragma("unroll") for (int k = 0; k < 2; ++k) dst[n][k] = *(const PG8_LAS bf16x8*)(lds + PG8_SB(b, h) + boff + n * 2048 + k * 1024); } while (0)
#define PG8_MMA(ai, bj, At, Bt) do { __builtin_amdgcn_s_setprio(1); _Pragma("unroll") for (int m = 0; m < 4; ++m) _Pragma("unroll") for (int n = 0; n < 2; ++n) _Pragma("unroll") for (int k = 0; k < 2; ++k) \
        acc[ai][bj][m][n] = __builtin_amdgcn_mfma_f32_16x16x32_bf16(Bt[n][k], At[m][k], acc[ai][bj][m][n], 0, 0, 0); __builtin_amdgcn_s_setprio(0); } while (0)
#define PG8_WAIT_V(n) asm volatile("s_waitcnt vmcnt(" #n ")" ::: "memory")
#define PG8_WAIT_L(n) asm volatile("s_waitcnt lgkmcnt(" #n ")" ::: "memory")
#define PG8_BAR __builtin_amdgcn_s_barrier()
#define PG8_SCHED __builtin_amdgcn_sched_barrier(0)
    Unit cur, nxt; int ui = 0;
    if (!S.next(0, cur)) return;
    f32x4 acc[2][2][4][2];
#pragma unroll
    for (int a = 0; a < 2; ++a)
#pragma unroll
        for (int b = 0; b < 2; ++b)
#pragma unroll
            for (int m = 0; m < 4; ++m)
#pragma unroll
                for (int n = 0; n < 2; ++n) acc[a][b][m][n] = (f32x4){0.f, 0.f, 0.f, 0.f};
    bf16x8 At[4][2], B0[2][2], B1[2][2];
    const char* cA = (const char*)g.A + (size_t)cur.pm * tstep; const char* cB = (const char*)g.Bt + (size_t)cur.pn * tstep;
    S.a_ready(cur);
    if constexpr (SP2) {
        PG8_STAGE(PG8_SB(0, 0), cB, voffB); PG8_STAGE(PG8_SB(0, 1), cB + hstep, voffB); PG8_STAGE(PG8_SA(0, 0), cA, voffA); PG8_STAGE(PG8_SA(0, 1), cA + hstep, voffA);
        if (wr == 1) PG8_BAR;
        PG8_WAIT_V(2); PG8_BAR;
        PG8_STAGE(PG8_SB(1, 0), cB + kstep, voffB); PG8_STAGE(PG8_SA(1, 0), cA + kstep, voffA); PG8_STAGE(PG8_SB(1, 1), cB + hstep + kstep, voffB);
        PG8_WAIT_V(6); PG8_BAR;
    } else {
        PG8_STAGE(PG8_SB(0, 0), cB, voffB); PG8_STAGE(PG8_SA(0, 0), cA, voffA); PG8_STAGE(PG8_SB(0, 1), cB + hstep, voffB); PG8_STAGE(PG8_SA(0, 1), cA + hstep, voffA);
        if (wr == 1) PG8_BAR;
        PG8_WAIT_V(4); PG8_BAR;
        PG8_STAGE(PG8_SB(1, 0), cB + kstep, voffB); PG8_STAGE(PG8_SA(1, 0), cA + kstep, voffA); PG8_STAGE(PG8_SB(1, 1), cB + hstep + kstep, voffB);
        PG8_WAIT_V(6); PG8_BAR;
    }
    for (;;) {
        const bool has_next = S.next(ui + 1, nxt);
        const char* nA = has_next ? (const char*)g.A + (size_t)nxt.pm * tstep : cA; const char* nB = has_next ? (const char*)g.Bt + (size_t)nxt.pn * tstep : cB;
        for (int t = 0; t < nt; t += 2) {
            const bool last = (t == nt - 2);
            const char* a1 = cA + (size_t)(t + 1) * kstep;
            const char* a2 = last ? nA : cA + (size_t)(t + 2) * kstep; const char* b2 = last ? nB : cB + (size_t)(t + 2) * kstep;
            const char* a3 = a2 + kstep; const char* b3 = b2 + kstep;
            if (last && has_next) S.a_ready(nxt);
            if constexpr (SP2) {
            PG8_LDB(B0, 0, 0); PG8_LDB(B1, 0, 1); PG8_SCHED; PG8_LDA(At, 0, 0); PG8_STAGE(PG8_SA(1, 1), a1 + hstep, voffA);
            PG8_WAIT_V(8); PG8_WAIT_L(0); PG8_BAR; PG8_MMA(0, 0, At, B0); PG8_MMA(0, 1, At, B1); PG8_BAR; PG8_SCHED;
            PG8_LDA(At, 0, 1); PG8_STAGE(PG8_SB(0, 0), b2, voffB); PG8_STAGE(PG8_SB(0, 1), b2 + hstep, voffB); PG8_STAGE(PG8_SA(0, 0), a2, voffA);
            PG8_WAIT_V(8); PG8_WAIT_L(0); PG8_BAR; PG8_MMA(1, 0, At, B0); PG8_MMA(1, 1, At, B1); PG8_BAR; PG8_SCHED;
            PG8_LDB(B0, 1, 0); PG8_LDB(B1, 1, 1); PG8_SCHED; PG8_LDA(At, 1, 0); PG8_STAGE(PG8_SA(0, 1), a2 + hstep, voffA);
            PG8_WAIT_V(8); PG8_WAIT_L(0); PG8_BAR; PG8_MMA(0, 0, At, B0); PG8_MMA(0, 1, At, B1); PG8_BAR; PG8_SCHED;
            PG8_LDA(At, 1, 1); PG8_STAGE(PG8_SB(1, 0), b3, voffB); PG8_STAGE(PG8_SB(1, 1), b3 + hstep, voffB); PG8_STAGE(PG8_SA(1, 0), a3, voffA);
            PG8_WAIT_V(8); PG8_WAIT_L(0); PG8_BAR; PG8_MMA(1, 0, At, B0); PG8_MMA(1, 1, At, B1); PG8_BAR; PG8_SCHED;
            } else {
            PG8_LDB(B0, 0, 0); PG8_SCHED; PG8_LDA(At, 0, 0); PG8_STAGE(PG8_SA(1, 1), a1 + hstep, voffA);
            PG8_WAIT_L(8); PG8_BAR; PG8_WAIT_L(0); PG8_MMA(0, 0, At, B0); PG8_BAR; PG8_SCHED;
            PG8_LDB(B1, 0, 1); PG8_STAGE(PG8_SB(0, 0), b2, voffB);
            PG8_BAR; PG8_WAIT_L(0); PG8_MMA(0, 1, At, B1); PG8_BAR;
            PG8_LDA(At, 0, 1); PG8_STAGE(PG8_SA(0, 0), a2, voffA);
            PG8_BAR; PG8_WAIT_L(0); PG8_MMA(1, 0, At, B0); PG8_BAR; PG8_SCHED;
            PG8_STAGE(PG8_SB(0, 1), b2 + hstep, voffB);
            PG8_WAIT_V(6); PG8_BAR; PG8_MMA(1, 1, At, B1); PG8_BAR;
            PG8_LDB(B0, 1, 0); PG8_SCHED; PG8_LDA(At, 1, 0); PG8_STAGE(PG8_SA(0, 1), a2 + hstep, voffA);
            PG8_WAIT_L(8); PG8_BAR; PG8_WAIT_L(0); PG8_MMA(0, 0, At, B0); PG8_BAR; PG8_SCHED;
            PG8_LDB(B1, 1, 1); PG8_STAGE(PG8_SB(1, 0), b3, voffB);
            PG8_BAR; PG8_WAIT_L(0); PG8_MMA(0, 1, At, B1); PG8_BAR;
            PG8_LDA(At, 1, 1); PG8_STAGE(PG8_SA(1, 0), a3, voffA);
            PG8_BAR; PG8_WAIT_L(0); PG8_MMA(1, 0, At, B0); PG8_BAR; PG8_SCHED;
            PG8_STAGE(PG8_SB(1, 1), b3 + hstep, voffB);
            PG8_WAIT_V(6); PG8_BAR; PG8_MMA(1, 1, At, B1); PG8_BAR;
            }
        }
        if constexpr (ALIGN_EPI) { if (wr == 0) PG8_BAR; }
        if constexpr (!Epi::AFTER_DRAIN) { E(acc, cur, wr, wc, fr, fq); S.done(cur); }
        if (!has_next) break;
#pragma unroll
        for (int a = 0; a < 2; ++a)
#pragma unroll
            for (int b = 0; b < 2; ++b)
#pragma unroll
                for (int m = 0; m < 4; ++m)
#pragma unroll
                    for (int n = 0; n < 2; ++n) acc[a][b][m][n] = (f32x4){0.f, 0.f, 0.f, 0.f};
        cur = nxt; cA = nA; cB = nB; ++ui;
        if constexpr (ALIGN_EPI) { if (wr == 1) PG8_BAR; }
    }
    PG8_WAIT_V(0);
    if constexpr (!ALIGN_EPI) { if (wr == 0) PG8_BAR; }
    PG8_BAR;
    if constexpr (Epi::AFTER_DRAIN) { E.fused(acc, cur, wr, wc, fr, fq, lds, wid, lane); S.done(cur); }
#undef PG8_SA
#undef PG8_SB
#undef PG8_STAGE
#undef PG8_LDA
#undef PG8_LDB
#undef PG8_MMA
#undef PG8_WAIT_V
#undef PG8_WAIT_L
#undef PG8_BAR
#undef PG8_SCHED
}
}
constexpr int NWAVES = 8;
constexpr int D = 1024, BATCH = 2, T = 8192, MP = BATCH * T, DEC_B = 128, DEC_T = 4, MS = DEC_B * DEC_T, M = MP + MS;
constexpr int NPA = 3584;
constexpr int CQ = 0, CKV = 512, CGATE = 1280, CZN = 1536, CU = 2048, CV = 2560, CZG = 3072;
constexpr int PROJ_A = 3352, N_POOL = 2560, NPAGES = 16, PAST = 2048;
constexpr float EPS = 1e-6f;
constexpr float SCL = 0.18033688011112042f;
constexpr float LOG2E = 1.4426950408889634f;

constexpr size_t MiB = 1u << 20;
constexpr size_t WS_CTL = 0, CTL_ZERO_BYTES = 1 * MiB;
constexpr size_t WS_WINA = 2 * MiB, WS_WOUTA = 16 * MiB, WS_WINC = 20 * MiB, WS_WOUTC = 28 * MiB, WS_WG = 32 * MiB, WS_WSP = 33 * MiB;
constexpr size_t WS_SSQ = 34 * MiB, WS_LSUM = 36 * MiB, WS_CARRY = 38 * MiB;
constexpr size_t WS_KCF = 40 * MiB, WS_VCF = 40 * MiB + 256 * 1024, WS_KCFS = 41 * MiB, WS_VCFS = 42 * MiB;
constexpr size_t WS_KSLC = 44 * MiB, WS_VSLC = 48 * MiB, WS_KWIN = 52 * MiB, WS_VWIN = 56 * MiB;
constexpr size_t WS_XG = 64 * MiB, WS_ACT2 = 98 * MiB, WS_Y = 132 * MiB, WS_MEAN = WS_Y  , WS_PEM = WS_Y + MiB  , WS_PROJ = 200 * MiB, WS_ATTPRE = 320 * MiB, WS_HP = 336 * MiB, WS_END = 400 * MiB;
static_assert(WS_XG + (size_t)M * D * 2 <= WS_ACT2 && WS_ACT2 + (size_t)M * D * 2 <= WS_Y && WS_Y + (size_t)M * D * 4 <= WS_PROJ && WS_PROJ + (size_t)M * NPA * 2 <= WS_ATTPRE, "d_ws map");
constexpr int CW_TMO = 0;
constexpr int CW_BAR = 4096;
constexpr int CW_GQ = 8192;

constexpr int RING_OFF = 0, RING_BYTES = 131072, SCRATCH_BYTES = 159744;
constexpr int LDSCTL_OFF = SCRATCH_BYTES, MISC_OFF = LDSCTL_OFF + 320;
constexpr int PTR_OFF = LDSCTL_OFF + 1024;
constexpr int LDS_BYTES = 163840;

#define GAS __attribute__((address_space(1)))
#define LAS __attribute__((address_space(3)))
typedef unsigned short bf16;
typedef unsigned v4u __attribute__((ext_vector_type(4)));
typedef unsigned v2u __attribute__((ext_vector_type(2)));
typedef float f32x4 __attribute__((ext_vector_type(4)));
typedef short bf16x8 __attribute__((ext_vector_type(8)));
typedef GAS unsigned gu32;
#define RLX_AGENT __ATOMIC_RELAXED, __HIP_MEMORY_SCOPE_AGENT
#define LDS_WAIT() asm volatile("s_waitcnt lgkmcnt(0)" ::: "memory")
#define VM_WAIT() asm volatile("s_waitcnt vmcnt(0)" ::: "memory")
#define LDS_BARRIER() do { asm volatile("s_waitcnt lgkmcnt(0)" ::: "memory"); __builtin_amdgcn_s_barrier(); asm volatile("" ::: "memory"); } while (0)
__device__ __forceinline__ unsigned f2bf(float f) { unsigned u = __builtin_bit_cast(unsigned, f); return (u + 0x7fffu + ((u >> 16) & 1u)) >> 16; }
__device__ __forceinline__ unsigned pk2(float lo, float hi) { return pg8::cvt_pk_bf16(lo, hi); }
__device__ __forceinline__ float bf2f(unsigned short v) { return __builtin_bit_cast(float, (unsigned)v << 16); }
__device__ __forceinline__ float bflo(unsigned w) { return __builtin_bit_cast(float, w << 16); }
__device__ __forceinline__ float bfhi(unsigned w) { return __builtin_bit_cast(float, w & 0xffff0000u); }
__device__ __forceinline__ float fexp2(float x) { return __builtin_amdgcn_exp2f(x); }
__device__ __forceinline__ float fsigmoid(float x) { return __builtin_amdgcn_rcpf(1.0f + fexp2(-x * LOG2E)); }
__device__ __forceinline__ float fsilu(float x) { return x * fsigmoid(x); }
__device__ __forceinline__ f32x4 mfma16(bf16x8 a, bf16x8 b, f32x4 c) { return __builtin_amdgcn_mfma_f32_16x16x32_bf16(a, b, c, 0, 0, 0); }
__device__ __forceinline__ bf16x8 pack8(const f32x4 a, const f32x4 b) { v4u w; w.x = pk2(a[0], a[1]); w.y = pk2(a[2], a[3]); w.z = pk2(b[0], b[1]); w.w = pk2(b[2], b[3]); return __builtin_bit_cast(bf16x8, w); }
__device__ __forceinline__ bf16x8 zero8() { v4u w = {0u, 0u, 0u, 0u}; return __builtin_bit_cast(bf16x8, w); }
__device__ __forceinline__ float wave_sum(float v) {
#pragma unroll
    for (int o = 1; o < 64; o <<= 1) v += __shfl_xor(v, o);
    return v;
}
__device__ __forceinline__ int rel_bucket(int d) {
    if (d < 16) return d;
    int b = 16;
    b += (d >= 21); b += (d >= 27); b += (d >= 35); b += (d >= 46); b += (d >= 59); b += (d >= 77); b += (d >= 99); b += (d >= 128);
    b += (d >= 166); b += (d >= 216); b += (d >= 280); b += (d >= 363); b += (d >= 470); b += (d >= 609); b += (d >= 790);
    return b;
}

#define XB_TMO      128
#define XB_XCNT(j)  (256  + 64 * (j))
#define XB_XSUB(j)  (1280 + 64 * (j))
#define XB_XGEN(j)  (2304 + 64 * (j))
#define XB_TOP      3328
#define XB_TOPGEN   3392
#define XCD_BAR_WORDS 3456
#define XB_SPIN_CAP (1u << 18)

__device__ __forceinline__ unsigned xb_ld(unsigned* p)              { return __hip_atomic_load(p, __ATOMIC_RELAXED, __HIP_MEMORY_SCOPE_AGENT); }
__device__ __forceinline__ unsigned xb_add(unsigned* p, unsigned v) { return __hip_atomic_fetch_add(p, v, __ATOMIC_RELAXED, __HIP_MEMORY_SCOPE_AGENT); }
__device__ __forceinline__ unsigned xb_xcc_id() { return (unsigned)__builtin_amdgcn_s_getreg((3 << 11) | 20) & 0xFu; }
#define XB_SPIN(cond, bar) do { unsigned _sp = 0; while (cond) { __builtin_amdgcn_s_sleep(1); \
    if ((++_sp & 255u) == 0u) { if (xb_ld(&(bar)[XB_TMO])) break; if (_sp > XB_SPIN_CAP) { atomicAdd(&(bar)[XB_TMO], 1u); break; } } } } while (0)

struct XcdBarrier {
    unsigned* bar; unsigned x;
    volatile LAS unsigned* st;
    bool w0;
};
__device__ __forceinline__ bool xb_leader(const XcdBarrier& b) { unsigned l_; asm volatile("v_mbcnt_lo_u32_b32 %0, -1, 0\n\tv_mbcnt_hi_u32_b32 %0, -1, %0" : "=v"(l_)); return b.w0 && l_ == 0u; }

__device__ __forceinline__ XcdBarrier xcd_barrier_post(unsigned* bar, volatile LAS unsigned* st, bool w0) {
    XcdBarrier b; b.bar = bar; b.x = xb_xcc_id(); b.st = st; b.w0 = w0;
    if (xb_leader(b)) (void)xb_add(&bar[XB_XCNT(b.x)], 1u);
    return b;
}
__device__ __forceinline__ void xcd_barrier_complete(unsigned* bar, unsigned x, unsigned& nloc, unsigned& nx) {
    const unsigned G = gridDim.x * gridDim.y * gridDim.z;
    unsigned sum, cnt, mine, sp = 0u;
    for (;;) {
        sum = 0u; cnt = 0u; mine = 0u;
#pragma unroll
        for (unsigned j = 0; j < 16; ++j) { const unsigned c = xb_ld(&bar[XB_XCNT(j)]); sum += c; cnt += (c > 0u) ? 1u : 0u; mine = (j == x) ? c : mine; }
        if (sum == G) break;
        __builtin_amdgcn_s_sleep(1);
        if ((++sp & 255u) == 0u) { if (xb_ld(&bar[XB_TMO])) break; if (sp > XB_SPIN_CAP) { atomicAdd(&bar[XB_TMO], 1u); break; } }
    }
    nloc = mine > 0u ? mine : 1u; nx = cnt > 0u ? cnt : 1u;
}

__device__ __forceinline__ void xcd_barrier(const XcdBarrier& b) {
    asm volatile("s_waitcnt vmcnt(0)" ::: "memory");
    __syncthreads();
    if (xb_leader(b)) {
        unsigned* bar = b.bar;
        __builtin_amdgcn_s_waitcnt(0);
        unsigned nloc = b.st[0], nx = b.st[1];
        if (nloc == 0u) { xcd_barrier_complete(bar, b.x, nloc, nx); b.st[0] = nloc; b.st[1] = nx; }
        const unsigned old = xb_add(&bar[XB_XSUB(b.x)], 1u);
        const unsigned gen = old / nloc;
        if (old + 1u == (gen + 1u) * nloc) {
            __builtin_amdgcn_fence(__ATOMIC_RELEASE, "agent");
            asm volatile("s_waitcnt vmcnt(0)" ::: "memory");
            const unsigned og = xb_add(&bar[XB_TOP], 1u);
            const unsigned tg = og / nx;
            if (og + 1u == (tg + 1u) * nx) xb_add(&bar[XB_TOPGEN], 1u);
            else XB_SPIN(xb_ld(&bar[XB_TOPGEN]) == tg, bar);
            __builtin_amdgcn_fence(__ATOMIC_ACQUIRE, "agent");
            xb_add(&bar[XB_XGEN(b.x)], 1u);
            asm volatile("s_waitcnt vmcnt(0)" ::: "memory");
        } else {
            XB_SPIN(xb_ld(&bar[XB_XGEN(b.x)]) == gen, bar);
            __builtin_amdgcn_fence(__ATOMIC_ACQUIRE, "agent");
            asm volatile("s_waitcnt vmcnt(0)" ::: "memory");
        }
    }
    __syncthreads();
}

struct Args { const void* in[29]; float* out; unsigned char* ws; int ph_lo, ph_hi, use_bar, pad; };
struct Frame {
    LAS unsigned char* lds;
    volatile LAS unsigned* MISC;
    gu32* ctl;
    int tid, lane, wave;
    int vcu, G;
    unsigned char* ws; float* out;
    __device__ __forceinline__ const void* inptr(int i) const {
        const LAS unsigned* t = (const LAS unsigned*)(lds + PTR_OFF) + 2 * i;
        const unsigned lo = (unsigned)__builtin_amdgcn_readfirstlane((int)t[0]), hi = (unsigned)__builtin_amdgcn_readfirstlane((int)t[1]);
        return (const void*)(const GAS void*)(((unsigned long long)hi << 32) | lo);
    }
    __device__ __forceinline__ const float* x_prompt() const { return (const float*)inptr(0); }
    __device__ __forceinline__ const float* x_sample() const { return (const float*)inptr(1); }
    __device__ __forceinline__ const float* cache_nsa() const { return (const float*)inptr(2); }
    __device__ __forceinline__ const float* cache_win() const { return (const float*)inptr(3); }
    __device__ __forceinline__ const float* state_h() const { return (const float*)inptr(4); }
    __device__ __forceinline__ const float* state_conv() const { return (const float*)inptr(5); }
    __device__ __forceinline__ const int* page_table() const { return (const int*)inptr(6); }
    __device__ __forceinline__ const float* norm_a() const { return (const float*)inptr(7); }
    __device__ __forceinline__ const float* w_in_a() const { return (const float*)inptr(8); }
    __device__ __forceinline__ const float* b_gate_a() const { return (const float*)inptr(9); }
    __device__ __forceinline__ const float* pe_cmp() const { return (const float*)inptr(10); }
    __device__ __forceinline__ const float* w_cmp() const { return (const float*)inptr(11); }
    __device__ __forceinline__ const float* ln_g() const { return (const float*)inptr(12); }
    __device__ __forceinline__ const float* ln_b() const { return (const float*)inptr(13); }
    __device__ __forceinline__ const float* w_sp() const { return (const float*)inptr(14); }
    __device__ __forceinline__ const float* b_sp() const { return (const float*)inptr(15); }
    __device__ __forceinline__ const float* w_out_a() const { return (const float*)inptr(16); }
    __device__ __forceinline__ const float* norm_c() const { return (const float*)inptr(17); }
    __device__ __forceinline__ const float* w_in_c() const { return (const float*)inptr(18); }
    __device__ __forceinline__ const float* conv_w() const { return (const float*)inptr(19); }
    __device__ __forceinline__ const float* conv_b() const { return (const float*)inptr(20); }
    __device__ __forceinline__ const float* w_rg_a() const { return (const float*)inptr(21); }
    __device__ __forceinline__ const float* b_rg_a() const { return (const float*)inptr(22); }
    __device__ __forceinline__ const float* w_rg_x() const { return (const float*)inptr(23); }
    __device__ __forceinline__ const float* b_rg_x() const { return (const float*)inptr(24); }
    __device__ __forceinline__ const float* lam() const { return (const float*)inptr(25); }
    __device__ __forceinline__ const float* w_out_c() const { return (const float*)inptr(26); }
    __device__ __forceinline__ const float* rel_bias() const { return (const float*)inptr(27); }
    __device__ __forceinline__ const float* final_norm() const { return (const float*)inptr(28); }
};
__device__ __forceinline__ int lane_id() { int l_; asm volatile("v_mbcnt_lo_u32_b32 %0, -1, 0\n\tv_mbcnt_hi_u32_b32 %0, -1, %0" : "=v"(l_)); return l_; }
__device__ __forceinline__ void relaunder(Frame& F) { int t_ = F.wave * 64 + lane_id(); asm volatile("" : "+v"(t_)); F.tid = t_; F.lane = t_ & 63;
    unsigned long long w_ = (unsigned long long)F.ws, o_ = (unsigned long long)F.out; asm volatile("" : "+s"(w_), "+s"(o_)); F.ws = (unsigned char*)(GAS unsigned char*)w_; F.out = (float*)(GAS float*)o_; }
constexpr size_t O_YP = 0, O_YS = O_YP + (size_t)MP * D, O_NSAP = O_YS + (size_t)MS * D, O_NSAS = O_NSAP + (size_t)2 * MP * 512, O_WINP = O_NSAS + (size_t)2 * MS * 512,
                 O_WINS = O_WINP + (size_t)2 * BATCH * 512 * 256, O_GV = O_WINS + (size_t)2 * MS * 256, O_HP = O_GV + (size_t)2 * MS * 512, O_HS = O_HP + (size_t)2 * BATCH * 1024,
                 O_CVP = O_HS + (size_t)2 * DEC_B * 1024, O_CVS = O_CVP + (size_t)2 * BATCH * 3 * 1024, O_END = O_CVS + (size_t)2 * DEC_B * 3 * 1024;
__device__ __forceinline__ void tr_item(const float* W, int ldw, int src_col0, int nvalid, int K, bf16* WT, int dst_row0, int k0, LAS float* scr, int lane, const float* gain = nullptr) {
    const int c = lane & 31;
    float wv[32];
#pragma unroll
    for (int i = 0; i < 32; ++i) { const int kk = 2 * i + (lane >> 5); wv[i] = (c < nvalid) ? __builtin_nontemporal_load(W + (size_t)(k0 + kk) * ldw + src_col0 + c) : 0.f; }
#pragma unroll
    for (int i = 0; i < 32; ++i) { const int kk = 2 * i + (lane >> 5); scr[kk * 33 + c] = gain ? wv[i] * gain[k0 + kk] : wv[i]; }
    LDS_WAIT(); asm volatile("" ::: "memory");
    const int c8 = lane & 7;
#pragma unroll
    for (int j = 0; j < 4; ++j) { const int n = (lane >> 3) + 8 * j; const LAS float* s = scr + (8 * c8) * 33 + n;
        v4u o; o.x = pk2(s[0 * 33], s[1 * 33]); o.y = pk2(s[2 * 33], s[3 * 33]); o.z = pk2(s[4 * 33], s[5 * 33]); o.w = pk2(s[6 * 33], s[7 * 33]);
        *(GAS v4u*)(WT + (size_t)(dst_row0 + n) * K + k0 + 8 * c8) = o; }
    LDS_WAIT(); asm volatile("" ::: "memory");
}
constexpr int P0_I_INA = 16 * (NPA / 32), P0_I_OUT = 16 * 32, P0_I_INC = 16 * 64, P0_I_G = 8;
constexpr int P0_NITEMS = 2 * P0_I_INA + 2 * P0_I_OUT + 2 * P0_I_INC + 2 * P0_I_OUT + 2 * 8 * 2 * P0_I_G;
__device__ __forceinline__ void p0_weights(Frame& F, int it0, int it1, int gw, int NGW) {
    LAS float* scr = (LAS float*)(F.lds + RING_OFF + F.wave * 16384);
    constexpr int I_INA = P0_I_INA, I_OUT = P0_I_OUT, I_INC = P0_I_INC, I_G = P0_I_G;
    for (int it = it0 + gw; it < it1; it += NGW) {
        int r = it;
        if (r < 2 * I_INA) { const int a = r / I_INA; r %= I_INA; const int kb = r / (NPA / 32), nb = r % (NPA / 32), n0 = nb * 32;
            int src = n0, nv = 32; if (n0 == 1280) nv = 24; else if (n0 > 1280 && n0 < CZN) nv = 0; else if (n0 >= CZN) src = n0 - (CZN - 1304);
            tr_item(F.w_in_a() + (size_t)a * D * PROJ_A, PROJ_A, src, nv, D, (bf16*)(F.ws + WS_WINA) + (size_t)a * NPA * D, n0, kb * 64, scr, F.lane, F.norm_a() + a * D); continue; }
        r -= 2 * I_INA;
        if (r < 2 * I_OUT) { const int a = r / I_OUT; r %= I_OUT; const int kb = r / 32, nb = r % 32;
            tr_item(F.w_out_a() + (size_t)a * D * D, D, nb * 32, 32, D, (bf16*)(F.ws + WS_WOUTA) + (size_t)a * D * D, nb * 32, kb * 64, scr, F.lane); continue; }
        r -= 2 * I_OUT;
        if (r < 2 * I_INC) { const int c = r / I_INC; r %= I_INC; const int kb = r / 64, nb = r % 64;
            tr_item(F.w_in_c() + (size_t)c * D * 2048, 2048, nb * 32, 32, D, (bf16*)(F.ws + WS_WINC) + (size_t)c * 2048 * D, nb * 32, kb * 64, scr, F.lane, F.norm_c() + c * D); continue; }
        r -= 2 * I_INC;
        if (r < 2 * I_OUT) { const int c = r / I_OUT; r %= I_OUT; const int kb = r / 32, nb = r % 32;
            tr_item(F.w_out_c() + (size_t)c * D * D, D, nb * 32, 32, D, (bf16*)(F.ws + WS_WOUTC) + (size_t)c * D * D, nb * 32, kb * 64, scr, F.lane); continue; }
        r -= 2 * I_OUT;
        {
            const int ch = r / (2 * I_G); r %= (2 * I_G); const int which = r / I_G; r %= I_G; const int kb = r / 4, nb = r % 4;
            const float* W = (which ? F.w_rg_x() : F.w_rg_a()) + (size_t)ch * 128 * 128;
            tr_item(W, 128, nb * 32, 32, 128, (bf16*)(F.ws + WS_WG) + (size_t)ch * 256 * 128, which * 128 + nb * 32, kb * 64, scr, F.lane); }
    }
}
__device__ __forceinline__ void p0_tril(Frame& F, int gt, int NT) {
    if (gt < 256) { const int a = gt >> 7, kv = (gt >> 6) & 1, dd = gt & 63; const float* pe = F.pe_cmp() + (size_t)a * 2 * 4096 + kv * 4096 + dd; float sm = 0.f;
#pragma unroll 16
        for (int c = 0; c < 64; ++c) sm += pe[c * 64];
        ((float*)(F.ws + WS_PEM))[gt] = sm * (1.0f / 64.0f); }
    bf16* wsp = (bf16*)(F.ws + WS_WSP);
    for (int e = gt; e < 2 * 4 * 128 * 128; e += NT) { const int j = e & 127, i = (e >> 7) & 127; wsp[e] = (bf16)((j <= i) ? f2bf(F.w_sp()[e]) : 0u); }
}
__device__ __forceinline__ void p0_late(Frame& F, int idx, int n) {
    p0_weights(F, P0_I_INA, P0_NITEMS, idx * NWAVES + F.wave, n * NWAVES);
    p0_tril(F, idx * (NWAVES * 64) + F.tid, n * NWAVES * 64);
}
__device__ __forceinline__ void p0_prologue(Frame& F, bool all) {
    const int gw = F.vcu * NWAVES + F.wave, NGW = F.G * NWAVES;
    p0_weights(F, 0, all ? P0_NITEMS : P0_I_INA, gw, NGW);
    if (all) p0_tril(F, F.vcu * (NWAVES * 64) + F.tid, F.G * NWAVES * 64);
    bf16* XG = (bf16*)(F.ws + WS_XG); float* SSQ = (float*)(F.ws + WS_SSQ);
    for (int m0 = gw; m0 < M; m0 += 4 * NGW) {
        f32x4 v[4][4];
#pragma unroll
        for (int q = 0; q < 4; ++q) { const int m = m0 + q * NGW; if (m < M) { const float* xrow = (m < MP) ? F.x_prompt() + (size_t)m * D : F.x_sample() + (size_t)(m - MP) * D; const GAS f32x4* xr = (const GAS f32x4*)xrow + F.lane;
#pragma unroll
                for (int j = 0; j < 4; ++j) v[q][j] = __builtin_nontemporal_load(xr + 64 * j); } }
#pragma unroll
        for (int q = 0; q < 4; ++q) { const int m = m0 + q * NGW; if (m < M) {
            float s = 0.f; GAS v2u* o8 = (GAS v2u*)(XG + (size_t)m * D) + F.lane;
#pragma unroll
            for (int j = 0; j < 4; ++j) { const f32x4 x = v[q][j]; s += (x.x * x.x + x.y * x.y) + (x.z * x.z + x.w * x.w);
                v2u w; w.x = pk2(x.x, x.y); w.y = pk2(x.z, x.w); o8[64 * j] = w; }
            s = wave_sum(s);
            if (F.lane < 16) SSQ[(size_t)m * 16 + F.lane] = (F.lane == 0) ? s : 0.f; } }
    }
}
__device__ __forceinline__ void p_final(Frame& F) {
    const int gw = F.vcu * NWAVES + F.wave, NGW = F.G * NWAVES;
    const bf16* R = (const bf16*)(F.ws + WS_XG); const float* SSQ = (const float*)(F.ws + WS_SSQ);
    const GAS f32x4* gr = (const GAS f32x4*)F.final_norm() + F.lane; f32x4 g[4];
#pragma unroll
    for (int j = 0; j < 4; ++j) g[j] = gr[64 * j];
    for (int m0 = gw; m0 < M; m0 += 4 * NGW) {
        v2u v[4][4]; float ri[4];
#pragma unroll
        for (int q = 0; q < 4; ++q) { const int m = m0 + q * NGW; if (m < M) { const GAS v2u* yr = (const GAS v2u*)(R + (size_t)m * D) + F.lane;
#pragma unroll
                for (int j = 0; j < 4; ++j) v[q][j] = __builtin_nontemporal_load(yr + 64 * j);
                ri[q] = pg8::row_rinv(SSQ, m); } }
#pragma unroll
        for (int q = 0; q < 4; ++q) { const int m = m0 + q * NGW; if (m < M) {
            GAS f32x4* o = (GAS f32x4*)(F.out + ((m < MP) ? O_YP + (size_t)m * D : O_YS + (size_t)(m - MP) * D)) + F.lane;
#pragma unroll
            for (int j = 0; j < 4; ++j) { const f32x4 y = {bflo(v[q][j].x), bfhi(v[q][j].x), bflo(v[q][j].y), bfhi(v[q][j].y)}; __builtin_nontemporal_store(y * ri[q] * g[j], o + 64 * j); } } }
    }
}
__device__ __forceinline__ int vkey(int ks2, int kq, int e) { return (2 * ks2 + (e >> 2)) * 16 + kq * 4 + (e & 3); }

constexpr int PREP_W = 8 * 9216, PREP_PE = PREP_W + 2 * 4096 * 4, PREP_VEC = PREP_PE + 2 * 64 * 4;
template <class DP>
__device__ __forceinline__ void cmp_matvec_store(Frame& F, int kv, const LAS float* vec, DP dstK, DP dstV, int blk, int nks2, int woff = PREP_W) {
    const LAS float* Wl = (const LAS float*)(F.lds + RING_OFF + woff) + kv * 4096 + F.lane; float o0 = 0.f, o1 = 0.f;
#pragma unroll 8
    for (int d = 0; d < 64; d += 4) { const f32x4 v4 = *(const LAS f32x4*)(vec + d);
        o0 += v4[0] * Wl[d * 64]; o1 += v4[1] * Wl[d * 64 + 64]; o0 += v4[2] * Wl[d * 64 + 128]; o1 += v4[3] * Wl[d * 64 + 192]; }
    const int e = F.lane; const bf16 ob = (bf16)f2bf(o0 + o1);
    if (kv == 0) { const int Tt = blk >> 4, r16 = blk & 15, ks = e >> 5, kq = (e & 31) >> 3, j = e & 7; dstK[((size_t)(Tt * 2 + ks) * 64 + r16 + 16 * kq) * 8 + j] = ob; }
    else { const int grp = blk >> 6, kb = blk & 63, t16 = kb >> 4, r = kb & 15, ks2 = t16 >> 1, ee = (t16 & 1) * 4 + (r & 3), kq = r >> 2, dt = e >> 4;
        dstV[((size_t)((grp * 4 + dt) * nks2 + ks2) * 64 + (e & 15) + 16 * kq) * 8 + ee] = ob; }
}

__device__ __forceinline__ void p_prep(Frame& F, int a) {
    const bf16* PROJ = (const bf16*)(F.ws + WS_PROJ);
    constexpr int NP = BATCH * 128, NSI = 0;
    {
        LAS float* Wl = (LAS float*)(F.lds + RING_OFF + PREP_W); LAS float* pem = (LAS float*)(F.lds + RING_OFF + PREP_PE);
        const float* wc = F.w_cmp() + (size_t)a * 2 * 4096;
        for (int e = F.tid; e < 2 * 4096; e += NWAVES * 64) Wl[e] = wc[e];
        if (F.tid < 128) pem[F.tid] = ((const float*)(F.ws + WS_PEM))[a * 128 + F.tid];
        LDS_WAIT(); __syncthreads();
    }
    const LAS float* pem = (const LAS float*)(F.lds + RING_OFF + PREP_PE);
    for (int it = F.vcu; it < NP + NSI; it += F.G) {
        relaunder(F);
        const int w = F.wave; LAS float* vec = (LAS float*)(F.lds + RING_OFF + PREP_VEC) + w * 64;
        {
            const int b = it >> 7, blk = it & 127;
            if (w < 4) {
                const int kv = w & 1, g = w >> 1;
                vec[F.lane] = ((const float*)(F.ws + WS_MEAN))[(((size_t)(b * 128 + blk) * 2 + kv) * 2 + g) * 64 + F.lane] + pem[kv * 64 + F.lane];
                LDS_WAIT(); asm volatile("" ::: "memory");
                cmp_matvec_store(F, kv, vec, (bf16*)(F.ws + WS_KCF) + (size_t)(b * 2 + g) * 8192, (bf16*)(F.ws + WS_VCF) + (size_t)(b * 2 + g) * 8192, blk, 2);
                LDS_WAIT(); asm volatile("" ::: "memory");
            }
        }
    }
}
constexpr int ATT_LUT = 0, ATT_LUTN = 1168, ATT_SCORE = 18944, ATT_SELM = ATT_SCORE + 16384, ATT_RING = 36864, ATT_NS = 6, ATT_SLOT = 16384, ATT_QF = ATT_RING + ATT_NS * ATT_SLOT  , ATT_VCF = ATT_RING + 4 * ATT_SLOT, ATT_MERGE = ATT_RING, ATT_FLAGS = ATT_RING - 64;
static_assert(ATT_SELM + 1024 <= ATT_RING && ATT_QF + 8 * 2048 <= SCRATCH_BYTES && ATT_MERGE + 8 * 2 * 18 * 64 * 4 <= SCRATCH_BYTES, "attention LDS map");
__device__ __forceinline__ float xrow16_max(float x) { x = fmaxf(x, __shfl_xor(x, 16)); return fmaxf(x, __shfl_xor(x, 32)); }
__device__ __forceinline__ float xrow16_sum(float x) { x += __shfl_xor(x, 16); return x + __shfl_xor(x, 32); }
template <int CTRL> __device__ __forceinline__ float dpp_q(float x) { return __builtin_bit_cast(float, __builtin_amdgcn_mov_dpp(__builtin_bit_cast(int, x), CTRL, 0xf, 0xf, true)); }
struct QState { float m, l; f32x4 o[4]; };
__device__ __forceinline__ void qs_init(QState& s) { s.m = -1e30f; s.l = 0.f;
#pragma unroll
    for (int i = 0; i < 4; ++i) s.o[i] = (f32x4){0.f, 0.f, 0.f, 0.f}; }

template <int MODE>
__device__ __forceinline__ void quad_qk(QState& st, bf16x8 (&pb)[2], const bf16x8 (&qf)[2], const bf16x8 (&kf)[8], int qpos, int kbase, bool colsel, const LAS float* lut, int kq) {
    f32x4 s[4];
#pragma unroll
    for (int kt = 0; kt < 4; ++kt) { s[kt] = (f32x4){0.f, 0.f, 0.f, 0.f}; s[kt] = mfma16(kf[kt * 2], qf[0], s[kt]); s[kt] = mfma16(kf[kt * 2 + 1], qf[1], s[kt]); }
    float mx = -1e30f;
#pragma unroll
    for (int kt = 0; kt < 4; ++kt)
#pragma unroll
        for (int i = 0; i < 4; ++i) {
            const int d = qpos - (kbase + kt * 16 + kq * 4 + i);
            const bool v = colsel && d >= 0 && (MODE == 0 || d <= 512);
            const int dd = d < 0 ? 0 : (d > 1023 ? 1023 : d);
            const float lb = lut[1023 - dd]; const float xv = v ? s[kt][i] * SCL + lb : -1e30f;
            s[kt][i] = xv; mx = fmaxf(mx, xv);
        }
    mx = xrow16_max(mx);
    const float mn = fmaxf(st.m, mx), alpha = fexp2(st.m - mn);
    float ls = 0.f;
#pragma unroll
    for (int kt = 0; kt < 4; ++kt)
#pragma unroll
        for (int i = 0; i < 4; ++i) { const float p = (s[kt][i] > -1e29f) ? fexp2(s[kt][i] - mn) : 0.f; s[kt][i] = p; ls += p; }
    st.l = st.l * alpha + ls; st.m = mn;
#pragma unroll
    for (int dt = 0; dt < 4; ++dt) st.o[dt] *= alpha;
    pb[0] = pack8(s[0], s[1]); pb[1] = pack8(s[2], s[3]);
}
__device__ __forceinline__ void quad_pv(QState& st, const bf16x8 (&pb)[2], const bf16x8 (&vf)[8]) {
#pragma unroll
    for (int dt = 0; dt < 4; ++dt) { st.o[dt] = mfma16(vf[dt * 2], pb[0], st.o[dt]); st.o[dt] = mfma16(vf[dt * 2 + 1], pb[1], st.o[dt]); }
}
__device__ __forceinline__ void qs_finish(QState& st) {
    const float l = xrow16_sum(st.l);
    const float inv = l > 0.f ? 1.0f / l : 0.f;
#pragma unroll
    for (int dt = 0; dt < 4; ++dt) st.o[dt] *= inv;
}

template <int NKT_MAX, int NKS2G, class KP, class VP>
__device__ __forceinline__ void quad_cmp(f32x4 (&o)[4], const bf16x8 (&qf)[2], KP kcf, VP vcf, int nkt, int qpos, const LAS float* lut, LAS float* score  , int lane) {
    const int kq = lane >> 4, c = lane & 15;
    f32x4 s[NKT_MAX]; float mx = -1e30f;
#pragma unroll
    for (int Tt = 0; Tt < NKT_MAX; ++Tt) {
        s[Tt] = (f32x4){0.f, 0.f, 0.f, 0.f};
        if (Tt < nkt) { s[Tt] = mfma16(kcf[(Tt * 2) * 64 + lane], qf[0], s[Tt]); s[Tt] = mfma16(kcf[(Tt * 2 + 1) * 64 + lane], qf[1], s[Tt]); }
#pragma unroll
        for (int i = 0; i < 4; ++i) {
            const int blk = Tt * 16 + kq * 4 + i, d = qpos - (blk * 64 + 63);
            const bool v = (Tt < nkt) && d >= 0; const int dd = d < 0 ? 0 : (d > 1023 ? 1023 : d);
            const float lb = lut[1023 - dd]; const float xv = v ? s[Tt][i] * SCL + lb : -1e30f; s[Tt][i] = xv; mx = fmaxf(mx, xv);
        }
    }
    mx = xrow16_max(mx);
    float ls = 0.f;
#pragma unroll
    for (int Tt = 0; Tt < NKT_MAX; ++Tt)
#pragma unroll
        for (int i = 0; i < 4; ++i) { const float p = (s[Tt][i] > -1e29f) ? fexp2(s[Tt][i] - mx) : 0.f; s[Tt][i] = p; ls += p; }
    ls = xrow16_sum(ls);
    const float inv = ls > 0.f ? 1.0f / ls : 0.f;
#pragma unroll
    for (int Tt = 0; Tt < NKT_MAX; ++Tt)
#pragma unroll
        for (int i = 0; i < 4; ++i) {
            const float p = s[Tt][i] * inv; s[Tt][i] = p;
            float sc = p + dpp_q<0xB1>(p); sc += dpp_q<0x4E>(sc);
            if ((c & 3) == 0 && Tt < nkt) score[(c >> 2) * 128 + Tt * 16 + kq * 4 + i] = sc;
        }
#pragma unroll
    for (int dt = 0; dt < 4; ++dt) o[dt] = (f32x4){0.f, 0.f, 0.f, 0.f};
#pragma unroll
    for (int KS = 0; KS < NKT_MAX / 2; ++KS) {
        if (2 * KS < nkt) {
            const bf16x8 pb = pack8(s[2 * KS], s[2 * KS + 1]);
            const int grp = (NKS2G == 2) ? (KS >> 1) : 0, ks2 = (NKS2G == 2) ? (KS & 1) : 0;
#pragma unroll
            for (int dt = 0; dt < 4; ++dt) o[dt] = mfma16(vcf[((grp * 4 + dt) * NKS2G + ks2) * 64 + lane], pb, o[dt]);
        }
    }
}

__device__ __forceinline__ void select_blocks(const LAS float* score, int cur, int lane, unsigned long long& m0, unsigned long long& m1) {
    const int nc = cur - 2;
    unsigned long long f0 = 1ull, f1 = 0ull;
    { const int a = cur, b = cur - 1; if (a < 64) f0 |= 1ull << a; else f1 |= 1ull << (a - 64); if (b >= 0) { if (b < 64) f0 |= 1ull << b; else f1 |= 1ull << (b - 64); } }
    if (nc <= 13) {
        m0 = (cur >= 63) ? ~0ull : ((1ull << (cur + 1)) - 1ull); m1 = (cur < 64) ? 0ull : ((cur - 64 >= 63) ? ~0ull : ((1ull << (cur - 64 + 1)) - 1ull));
        return; }
    const int j0 = lane, j1 = lane + 64;
    const bool v0 = (j0 >= 1 && j0 <= cur - 2), v1 = (j1 <= cur - 2);
    const unsigned k0 = v0 ? (__builtin_bit_cast(unsigned, score[j0]) + 1u) : 0u, k1 = v1 ? (__builtin_bit_cast(unsigned, score[j1]) + 1u) : 0u;
    unsigned t = 0u;
    for (int bit = 30; bit >= 0; --bit) {
        const unsigned cand = t | (1u << bit);
        const int cnt = __popcll(__ballot(k0 >= cand)) + __popcll(__ballot(k1 >= cand));
        if (cnt >= 13) t = cand;
    }
    const bool g0 = k0 > t, g1 = k1 > t, e0 = (k0 == t), e1 = (k1 == t);
    const unsigned long long bg0 = __ballot(g0), bg1 = __ballot(g1), be0 = __ballot(e0), be1 = __ballot(e1);
    const int need = 13 - (__popcll(bg0) + __popcll(bg1));
    const unsigned long long lt = (lane == 0) ? 0ull : (~0ull >> (64 - lane));
    const int r0 = __popcll(be0 & lt), r1 = __popcll(be0) + __popcll(be1 & lt);
    const bool s0 = g0 || (e0 && r0 < need), s1 = g1 || (e1 && r1 < need);
    m0 = __ballot(s0) | f0; m1 = __ballot(s1) | f1;
}
__device__ __forceinline__ void load_frags8(bf16x8 (&f)[8], const bf16x8* base, int lane) {
#pragma unroll
    for (int i = 0; i < 8; ++i) f[i] = base[i * 64 + lane];
}
__device__ __forceinline__ void build_lut(Frame& F, int g) {
    LAS float* lut = (LAS float*)(F.lds + RING_OFF + ATT_LUT); const float* rb = F.rel_bias();
    for (int e = F.tid; e < 4 * ATT_LUTN; e += NWAVES * 64) { const int h = e / ATT_LUTN, idx = e - h * ATT_LUTN, d = 1023 - idx; lut[e] = d >= 0 ? rb[rel_bucket(d) * 8 + 4 * g + h] * LOG2E : 0.f; }
}
template <int BIAS, int MASK>
__device__ __forceinline__ void quad_qk2(QState& st, bf16x8 (&pb)[2], const bf16x8 (&qf)[2], const bf16x8 (&kf)[8], float cinit, const LAS float* lutp, int dk) {
    f32x4 s[4];
#pragma unroll
    for (int kt = 0; kt < 4; ++kt) { s[kt] = (f32x4){cinit, cinit, cinit, cinit}; s[kt] = mfma16(kf[kt * 2], qf[0], s[kt]); s[kt] = mfma16(kf[kt * 2 + 1], qf[1], s[kt]); }
    float mx;
    if (BIAS == 0 && MASK == 0) {
        const float m0 = fmaxf(fmaxf(s[0][0], s[0][1]), fmaxf(s[0][2], s[0][3])), m1 = fmaxf(fmaxf(s[1][0], s[1][1]), fmaxf(s[1][2], s[1][3]));
        const float m2 = fmaxf(fmaxf(s[2][0], s[2][1]), fmaxf(s[2][2], s[2][3])), m3 = fmaxf(fmaxf(s[3][0], s[3][1]), fmaxf(s[3][2], s[3][3]));
        mx = fmaxf(fmaxf(m0, m1), fmaxf(m2, m3)) * SCL;
    } else {
        mx = -1e30f;
#pragma unroll
        for (int kt = 0; kt < 4; ++kt)
#pragma unroll
            for (int i = 0; i < 4; ++i) {
                float x = s[kt][i] * SCL + (BIAS ? lutp[kt * 16 + i] : 0.f);
                if (MASK == 1) x = (dk - (kt * 16 + i) >= 0) ? x : -1e30f;
                if (MASK == 2) x = (dk - (kt * 16 + i) <= 512) ? x : -1e30f;
                s[kt][i] = x; mx = fmaxf(mx, x);
            }
    }
    mx = xrow16_max(mx);
    if (__any(mx > st.m)) {
        const float mn = fmaxf(st.m, mx), alpha = fexp2(st.m - mn); st.l *= alpha; st.m = mn;
#pragma unroll
        for (int dt = 0; dt < 4; ++dt) st.o[dt] *= alpha;
    }
    const float mn = st.m; float ls = 0.f;
#pragma unroll
    for (int kt = 0; kt < 4; ++kt)
#pragma unroll
        for (int i = 0; i < 4; ++i) { const float p = (BIAS == 0 && MASK == 0) ? fexp2(s[kt][i] * SCL - mn) : fexp2(s[kt][i] - mn); s[kt][i] = p; ls += p; }
    st.l += ls;
    pb[0] = pack8(s[0], s[1]); pb[1] = pack8(s[2], s[3]);
}
constexpr float ATT_THR = 8.0f;
#ifndef PROBE_RING
#define PROBE_RING 0
#endif
template <int BIAS, int MASK, bool A0, bool A1>
__device__ __forceinline__ void qk_pair(QState (&st)[2], bf16x8 (&pb)[2][2], const bf16x8 (&qf)[2][2], const bf16x8 (&kf)[8], float c0, float c1, const LAS float* lp0, const LAS float* lp1, int dk0, int dk1) {
    f32x4 s[2][4]; float mx[2], mb[2];
#pragma unroll
    for (int qd = 0; qd < 2; ++qd) { if (!(qd ? A1 : A0)) continue;
        mb[qd] = (BIAS == 0 && MASK == 0) ? (st[qd].m > -1e29f ? st[qd].m : 0.f) : 0.f;
        const float ci = (qd ? c1 : c0) - mb[qd];
#pragma unroll
        for (int kt = 0; kt < 4; ++kt) { s[qd][kt] = (f32x4){ci, ci, ci, ci}; s[qd][kt] = mfma16(kf[kt * 2], qf[qd][0], s[qd][kt]); s[qd][kt] = mfma16(kf[kt * 2 + 1], qf[qd][1], s[qd][kt]); } }
    if (BIAS == 0 && MASK == 0) {
        bool trig = false;
#pragma unroll
        for (int qd = 0; qd < 2; ++qd) { if (!(qd ? A1 : A0)) { mx[qd] = -3e38f; continue; }
            const float m0 = fmaxf(fmaxf(s[qd][0][0], s[qd][0][1]), fmaxf(s[qd][0][2], s[qd][0][3])), m1 = fmaxf(fmaxf(s[qd][1][0], s[qd][1][1]), fmaxf(s[qd][1][2], s[qd][1][3]));
            const float m2 = fmaxf(fmaxf(s[qd][2][0], s[qd][2][1]), fmaxf(s[qd][2][2], s[qd][2][3])), m3 = fmaxf(fmaxf(s[qd][3][0], s[qd][3][1]), fmaxf(s[qd][3][2], s[qd][3][3]));
            mx[qd] = fmaxf(fmaxf(m0, m1), fmaxf(m2, m3));
            trig = trig || (mx[qd] > ATT_THR) || (st[qd].m < -1e29f && mx[qd] > -1e29f); }
        if (__any(trig)) {
#pragma unroll
            for (int qd = 0; qd < 2; ++qd) { if (!(qd ? A1 : A0)) continue;
                const float mc = xrow16_max(mx[qd]), mabs = mc > -1e29f ? mb[qd] + mc : -1e30f;
                const float mn = fmaxf(st[qd].m, mabs), alpha = fexp2(st[qd].m - mn), sh = mn - mb[qd];
                st[qd].l *= alpha; st[qd].m = mn;
#pragma unroll
                for (int dt = 0; dt < 4; ++dt) st[qd].o[dt] *= alpha;
#pragma unroll
                for (int kt = 0; kt < 4; ++kt) s[qd][kt] -= sh; }
        }
#pragma unroll
        for (int qd = 0; qd < 2; ++qd) { if (!(qd ? A1 : A0)) continue;
            float ls = 0.f;
#pragma unroll
            for (int kt = 0; kt < 4; ++kt)
#pragma unroll
                for (int i = 0; i < 4; ++i) { const float p = fexp2(s[qd][kt][i]); s[qd][kt][i] = p; ls += p; }
            st[qd].l += ls;
            pb[qd][0] = pack8(s[qd][0], s[qd][1]); pb[qd][1] = pack8(s[qd][2], s[qd][3]); }
        return;
    }
#pragma unroll
    for (int qd = 0; qd < 2; ++qd) { if (!(qd ? A1 : A0)) { mx[qd] = -3e38f; continue; }
        const int dk = qd ? dk1 : dk0; const LAS float* lp = qd ? lp1 : lp0;
        float m = -1e30f;
#pragma unroll
        for (int kt = 0; kt < 4; ++kt)
#pragma unroll
            for (int i = 0; i < 4; ++i) {
                float x = s[qd][kt][i] + (BIAS ? lp[kt * 16 + i] : 0.f);
                if (MASK == 1) x = (dk - (kt * 16 + i) >= 0) ? x : -1e30f;
                if (MASK == 2) x = (dk - (kt * 16 + i) <= 512) ? x : -1e30f;
                s[qd][kt][i] = x; m = fmaxf(m, x);
            }
        mx[qd] = xrow16_max(m);
    }
    if (__any((A0 && mx[0] > st[0].m) || (A1 && mx[1] > st[1].m))) {
#pragma unroll
        for (int qd = 0; qd < 2; ++qd) { if (!(qd ? A1 : A0)) continue;
            const float mn = fmaxf(st[qd].m, mx[qd]), alpha = fexp2(st[qd].m - mn); st[qd].l *= alpha; st[qd].m = mn;
#pragma unroll
            for (int dt = 0; dt < 4; ++dt) st[qd].o[dt] *= alpha; }
    }
#pragma unroll
    for (int qd = 0; qd < 2; ++qd) { if (!(qd ? A1 : A0)) continue;
        const float mn = st[qd].m; float ls = 0.f;
#pragma unroll
        for (int kt = 0; kt < 4; ++kt)
#pragma unroll
            for (int i = 0; i < 4; ++i) { const float p = fexp2(s[qd][kt][i] - mn); s[qd][kt][i] = p; ls += p; }
        st[qd].l += ls;
        pb[qd][0] = pack8(s[qd][0], s[qd][1]); pb[qd][1] = pack8(s[qd][2], s[qd][3]); }
}
template <bool A0, bool A1>
__device__ __forceinline__ void pv_pair(QState (&st)[2], const bf16x8 (&pb)[2][2], const bf16x8 (&vf)[8]) {
#pragma unroll
    for (int dt = 0; dt < 4; ++dt) {
        if (A0) { st[0].o[dt] = mfma16(vf[dt * 2], pb[0][0], st[0].o[dt]); st[0].o[dt] = mfma16(vf[dt * 2 + 1], pb[0][1], st[0].o[dt]); }
        if (A1) { st[1].o[dt] = mfma16(vf[dt * 2], pb[1][0], st[1].o[dt]); st[1].o[dt] = mfma16(vf[dt * 2 + 1], pb[1][1], st[1].o[dt]); } }
}
__device__ __forceinline__ void nsa_store(Frame& F, int a, int row, int head, const f32x4 (&oc)[4], const f32x4 (&os)[4], const f32x4 (&ow)[4], int kq) {
    const bf16* PROJ = (const bf16*)(F.ws + WS_PROJ); bf16* YCAT = (bf16*)(F.ws + WS_ACT2);
    const bf16* pr = PROJ + (size_t)row * NPA; const float* bg = F.b_gate_a() + a * 24;
    const float g0 = fsigmoid(bf2f(pr[CGATE + head]) + bg[head]), g1 = fsigmoid(bf2f(pr[CGATE + 8 + head]) + bg[8 + head]), g2 = fsigmoid(bf2f(pr[CGATE + 16 + head]) + bg[16 + head]);
#pragma unroll
    for (int dt = 0; dt < 4; ++dt) {
        const int dim = dt * 16 + kq * 4; const v2u z = *(const v2u*)(pr + CZN + head * 64 + dim);
        const f32x4 o = oc[dt] * g0 + os[dt] * g1 + ow[dt] * g2;
        v2u w; w.x = pk2(o[0] * fsilu(bflo(z.x)), o[1] * fsilu(bfhi(z.x))); w.y = pk2(o[2] * fsilu(bflo(z.y)), o[3] * fsilu(bfhi(z.y)));
        *(v2u*)(YCAT + (size_t)row * D + head * 64 + dim) = w;
    }
}

__device__ __forceinline__ void att_issue(const bf16x8* kb, const bf16x8* vb, int j, LAS unsigned char* slot, int w, int lane) {
    const GAS unsigned char* base = (const GAS unsigned char*)((w < 4) ? kb : vb) + ((size_t)j * 512 + (size_t)((2 * w) & 7) * 64) * 16;
    unsigned voff = (unsigned)lane * 16u; asm volatile("" : "+v"(voff));
    LAS unsigned char* dst = slot + (2 * w) * 1024;
    __builtin_amdgcn_global_load_lds((const GAS unsigned*)(base + voff), (LAS unsigned*)dst, 16, 0, 0);
    __builtin_amdgcn_global_load_lds((const GAS unsigned*)(base + 1024 + voff), (LAS unsigned*)(dst + 1024), 16, 0, 0);
}
__device__ __forceinline__ void attn_prompt_unit(Frame& F, int a, int b, int g, int qt) {
    const bf16* PROJ = (const bf16*)(F.ws + WS_PROJ);
    const int lane = F.lane, w = F.wave, kq = lane >> 4, c = lane & 15, ql = c >> 2, h = c & 3, cur = qt, t0 = qt * 64;
    const LAS float* lut = (const LAS float*)(F.lds + RING_OFF + ATT_LUT) + h * ATT_LUTN;
    LAS float* score = (LAS float*)(F.lds + RING_OFF + ATT_SCORE) + w * 512;
    LAS unsigned long long* selm = (LAS unsigned long long*)(F.lds + RING_OFF + ATT_SELM) + w * 16;
    LAS unsigned char* ring = F.lds + RING_OFF + ATT_RING;
    const size_t bg = (size_t)(b * 2 + g);
    const bf16x8* KS = (const bf16x8*)(F.ws + WS_KSLC) + bg * 128 * 512; const bf16x8* VS = (const bf16x8*)(F.ws + WS_VSLC) + bg * 128 * 512;
    const bf16x8* KW = (const bf16x8*)(F.ws + WS_KWIN) + bg * 128 * 512; const bf16x8* VW = (const bf16x8*)(F.ws + WS_VWIN) + bg * 128 * 512;
    const int jw0 = cur - 8 < 0 ? 0 : cur - 8, nw = cur - jw0 + 1, n = nw + cur + 1;
#define ATT_ISSUE(it) do { const int it_ = (it); if (it_ < nw) att_issue(KW, VW, jw0 + it_, ring + (it_ % ATT_NS) * ATT_SLOT, w, lane); else att_issue(KS, VS, it_ - nw, ring + (it_ % ATT_NS) * ATT_SLOT, w, lane); } while (0)
    { const bf16x8* ksrc = (const bf16x8*)(F.ws + WS_KCF) + bg * 1024 + (size_t)(2 * w) * 64 + lane; const bf16x8* vsrc = (const bf16x8*)(F.ws + WS_VCF) + bg * 1024 + (size_t)(2 * w) * 64 + lane;
      LAS unsigned char* kd = ring + 3 * ATT_SLOT + (2 * w) * 1024; LAS unsigned char* vd = F.lds + RING_OFF + ATT_VCF + (2 * w) * 1024;
      __builtin_amdgcn_global_load_lds((const unsigned*)ksrc, (LAS unsigned*)kd, 16, 0, 0); __builtin_amdgcn_global_load_lds((const unsigned*)(ksrc + 64), (LAS unsigned*)(kd + 1024), 16, 0, 0);
      __builtin_amdgcn_global_load_lds((const unsigned*)vsrc, (LAS unsigned*)vd, 16, 0, 0); __builtin_amdgcn_global_load_lds((const unsigned*)(vsrc + 64), (LAS unsigned*)(vd + 1024), 16, 0, 0); }
    ATT_ISSUE(0); if (n > 1) ATT_ISSUE(1); if (n > 2) ATT_ISSUE(2);
    unsigned* prel = (unsigned*)(F.ws + WS_ATTPRE) + ((size_t)blockIdx.x * 8 + w) * 1280 + 4 * 64 + lane;
    const int nkt = 2 * (cur / 32 + 1);
    bf16x8 qf[2][2]; f32x4 pre[2][4]; int qpos[2]; unsigned long long u0[2], u1[2]; float gt0[2], gt1[2], gt2[2];
    { unsigned short gl[2][3]; float gb[3];
#pragma unroll
      for (int qd = 0; qd < 2; ++qd) { qpos[qd] = t0 + w * 8 + qd * 4 + ql; const bf16* pr = PROJ + (size_t)(b * T + qpos[qd]) * NPA;
#pragma unroll
          for (int ks = 0; ks < 2; ++ks) qf[qd][ks] = *(const bf16x8*)(pr + CQ + (4 * g + h) * 64 + ks * 32 + kq * 8);
#pragma unroll
          for (int br = 0; br < 3; ++br) gl[qd][br] = pr[CGATE + 8 * br + 4 * g + h]; }
      const float* bgp = F.b_gate_a() + a * 24 + 4 * g + h;
#pragma unroll
      for (int br = 0; br < 3; ++br) gb[br] = bgp[8 * br];
#pragma unroll
      for (int qd = 0; qd < 2; ++qd) { gt0[qd] = fsigmoid(bf2f(gl[qd][0]) + gb[0]); gt1[qd] = fsigmoid(bf2f(gl[qd][1]) + gb[1]); gt2[qd] = fsigmoid(bf2f(gl[qd][2]) + gb[2]);
          prel[(qd - 4) * 64] = __builtin_bit_cast(unsigned, gt1[qd]); prel[(qd - 2) * 64] = __builtin_bit_cast(unsigned, gt2[qd]); } }
    asm volatile("s_waitcnt vmcnt(0)" ::: "memory"); LDS_BARRIER();
#pragma unroll
    for (int qd = 0; qd < 2; ++qd) {
        quad_cmp<8, 2>(pre[qd], qf[qd], (const LAS bf16x8*)(ring + 3 * ATT_SLOT), (const LAS bf16x8*)(F.lds + RING_OFF + ATT_VCF), nkt, qpos[qd], lut, score, lane);
        LDS_WAIT(); asm volatile("" ::: "memory");
        unsigned long long uu0 = 0ull, uu1 = 0ull, mm0 = 0ull, mm1 = 0ull;
        for (int q = 0; q < 4; ++q) { unsigned long long m0, m1; select_blocks(score + q * 128, cur, lane, m0, m1); uu0 |= m0; uu1 |= m1; if (q == ql) { mm0 = m0; mm1 = m1; } }
        selm[(qd * 4 + ql) * 2] = mm0; selm[(qd * 4 + ql) * 2 + 1] = mm1;
        u0[qd] = ((unsigned long long)(unsigned)__builtin_amdgcn_readfirstlane((int)(unsigned)(uu0 >> 32)) << 32) | (unsigned)__builtin_amdgcn_readfirstlane((int)(unsigned)uu0);
        u1[qd] = ((unsigned long long)(unsigned)__builtin_amdgcn_readfirstlane((int)(unsigned)(uu1 >> 32)) << 32) | (unsigned)__builtin_amdgcn_readfirstlane((int)(unsigned)uu1);
        LDS_WAIT(); asm volatile("" ::: "memory");
#pragma unroll
        for (int dt = 0; dt < 4; ++dt) { const f32x4 pv = pre[qd][dt] * gt0[qd]; prel[((qd * 4 + dt) * 2) * 64] = pk2(pv[0], pv[1]); prel[((qd * 4 + dt) * 2 + 1) * 64] = pk2(pv[2], pv[3]); }
    }
    QState st[2]; qs_init(st[0]); qs_init(st[1]);
    LAS bf16x8* qfl0 = (LAS bf16x8*)score + lane; LAS bf16x8* qfl1 = (LAS bf16x8*)(F.lds + RING_OFF + ATT_QF) + w * 128 + lane;
#pragma unroll
    for (int qd = 0; qd < 2; ++qd)
#pragma unroll
        for (int ks = 0; ks < 2; ++ks) { const v4u r = __builtin_bit_cast(v4u, qf[qd][ks]); v4u o;
            o.x = pk2(bflo(r.x) * SCL, bfhi(r.x) * SCL); o.y = pk2(bflo(r.y) * SCL, bfhi(r.y) * SCL); o.z = pk2(bflo(r.z) * SCL, bfhi(r.z) * SCL); o.w = pk2(bflo(r.w) * SCL, bfhi(r.w) * SCL);
            (qd ? qfl1 : qfl0)[ks * 64] = __builtin_bit_cast(bf16x8, o); }
    const int npair = (n + 2) / 3;
#pragma nounroll
    for (int kp = 0; kp < npair; ++kp) {
        asm volatile("s_waitcnt vmcnt(0)" ::: "memory");
        asm volatile("s_waitcnt lgkmcnt(0)" ::: "memory"); __builtin_amdgcn_s_barrier(); asm volatile("" ::: "memory");
        { const int i0 = 3 * kp + 3; if (i0 < n) ATT_ISSUE(i0); if (i0 + 1 < n) ATT_ISSUE(i0 + 1); if (i0 + 2 < n) ATT_ISSUE(i0 + 2); }
#pragma nounroll
      for (int hh = 0; hh < 3; ++hh) {
        const int it = 3 * kp + hh; if (it >= n) break;
        const LAS bf16x8* slot = (const LAS bf16x8*)(ring + (it % ATT_NS) * ATT_SLOT) + lane;
        const int j = it < nw ? jw0 + it : it - nw;
        const int D0a = qpos[0] - j * 64, D0b = qpos[1] - j * 64;
        const LAS float* lpa = lut + (1023 - D0a + 4 * kq); const LAS float* lpb = lut + (1023 - D0b + 4 * kq); const int dka = D0a - 4 * kq, dkb = D0b - 4 * kq;
        bf16x8 fr[8], frv[8], pb[2][2], qfr[2][2];
#define LOADQ() do { qfr[0][0] = qfl0[0]; qfr[0][1] = qfl0[64]; qfr[1][0] = qfl1[0]; qfr[1][1] = qfl1[64]; } while (0)
#define LOADK() do { _Pragma("unroll") for (int f = 0; f < 8; ++f) { fr[f] = slot[f * 64]; frv[f] = slot[(8 + f) * 64]; } } while (0)
#define LOADV() do { } while (0)
        if (it < nw) {
            LOADQ(); LOADK();
            if (j == cur) qk_pair<1, 1, true, true>(st, pb, qfr, fr, 0.f, 0.f, lpa, lpb, dka, dkb);
            else if (j == cur - 8) qk_pair<1, 2, true, true>(st, pb, qfr, fr, 0.f, 0.f, lpa, lpb, dka, dkb);
            else qk_pair<1, 0, true, true>(st, pb, qfr, fr, 0.f, 0.f, lpa, lpb, dka, dkb);
            LOADV(); pv_pair<true, true>(st, pb, frv);
            if (it == nw - 1) {
#pragma unroll
                for (int qd = 0; qd < 2; ++qd) { qs_finish(st[qd]); const float g2 = __builtin_bit_cast(float, __hip_atomic_load(prel + (qd - 2) * 64, RLX_AGENT));
#pragma unroll
                    for (int dt = 0; dt < 4; ++dt) { const unsigned pa = __hip_atomic_load(prel + ((qd * 4 + dt) * 2) * 64, RLX_AGENT), pc = __hip_atomic_load(prel + ((qd * 4 + dt) * 2 + 1) * 64, RLX_AGENT); const f32x4 pv = (f32x4){bflo(pa), bfhi(pa), bflo(pc), bfhi(pc)} + st[qd].o[dt] * g2; prel[((qd * 4 + dt) * 2) * 64] = pk2(pv[0], pv[1]); prel[((qd * 4 + dt) * 2 + 1) * 64] = pk2(pv[2], pv[3]); }
                    qs_init(st[qd]); }
            }
        } else {
            const bool a0 = __builtin_amdgcn_readfirstlane((int)((((j < 64 ? u0[0] : u1[0]) >> (j & 63)) & 1ull) != 0ull)) != 0, a1 = __builtin_amdgcn_readfirstlane((int)((((j < 64 ? u0[1] : u1[1]) >> (j & 63)) & 1ull) != 0ull)) != 0;
            if (a0 || a1) {
                const bool sel0 = ((selm[ql * 2 + (j >> 6)] >> (j & 63)) & 1ull) != 0ull, sel1 = ((selm[(4 + ql) * 2 + (j >> 6)] >> (j & 63)) & 1ull) != 0ull;
                LOADQ(); LOADK();
                if (t0 + w * 8 - (j * 64 + 63) >= 790) {
                    const float b31s = lut[0];
                    const float c0 = sel0 ? b31s : -1e30f, c1 = sel1 ? b31s : -1e30f;
                    if (a0 && a1) { qk_pair<0, 0, true, true>(st, pb, qfr, fr, c0, c1, lpa, lpb, dka, dkb); LOADV(); pv_pair<true, true>(st, pb, frv); }
                    else if (a0) { qk_pair<0, 0, true, false>(st, pb, qfr, fr, c0, c1, lpa, lpb, dka, dkb); LOADV(); pv_pair<true, false>(st, pb, frv); }
                    else { qk_pair<0, 0, false, true>(st, pb, qfr, fr, c0, c1, lpa, lpb, dka, dkb); LOADV(); pv_pair<false, true>(st, pb, frv); }
                } else {
                    const float c0 = sel0 ? 0.f : -1e30f, c1 = sel1 ? 0.f : -1e30f;
                    if (j == cur) { qk_pair<1, 1, true, true>(st, pb, qfr, fr, c0, c1, lpa, lpb, dka, dkb); LOADV(); pv_pair<true, true>(st, pb, frv); }
                    else if (a0 && a1) { qk_pair<1, 0, true, true>(st, pb, qfr, fr, c0, c1, lpa, lpb, dka, dkb); LOADV(); pv_pair<true, true>(st, pb, frv); }
                    else if (a0) { qk_pair<1, 0, true, false>(st, pb, qfr, fr, c0, c1, lpa, lpb, dka, dkb); LOADV(); pv_pair<true, false>(st, pb, frv); }
                    else { qk_pair<1, 0, false, true>(st, pb, qfr, fr, c0, c1, lpa, lpb, dka, dkb); LOADV(); pv_pair<false, true>(st, pb, frv); }
                }
            }
        }
#undef LOADK
#undef LOADQ
#undef LOADV
      }
    }
#undef ATT_ISSUE
    int lane2 = lane; asm volatile("" : "+v"(lane2)); const int kq2 = lane2 >> 4, h2 = lane2 & 3, ql2 = (lane2 & 15) >> 2;
#pragma unroll
    for (int qd = 0; qd < 2; ++qd) {
        qs_finish(st[qd]);
        const int row = b * T + t0 + w * 8 + qd * 4 + ql2, head = 4 * g + h2;
        const bf16* pr = PROJ + (size_t)row * NPA; bf16* YCAT = (bf16*)(F.ws + WS_ACT2);
        const float g1 = __builtin_bit_cast(float, __hip_atomic_load(prel + (qd - 4) * 64, RLX_AGENT));
#pragma unroll
        for (int dt = 0; dt < 4; ++dt) { const int dim = dt * 16 + kq2 * 4; const v2u z = *(const v2u*)(pr + CZN + head * 64 + dim);
            v2u pq; pq.x = __hip_atomic_load(prel + ((qd * 4 + dt) * 2) * 64, RLX_AGENT); pq.y = __hip_atomic_load(prel + ((qd * 4 + dt) * 2 + 1) * 64, RLX_AGENT); const f32x4 o = (f32x4){bflo(pq.x), bfhi(pq.x), bflo(pq.y), bfhi(pq.y)} + st[qd].o[dt] * g1;
            v2u wv; wv.x = pk2(o[0] * fsilu(bflo(z.x)), o[1] * fsilu(bfhi(z.x))); wv.y = pk2(o[2] * fsilu(bflo(z.y)), o[3] * fsilu(bfhi(z.y)));
            *(v2u*)(YCAT + (size_t)row * D + head * 64 + dim) = wv; }
    }
}

template <class RowF> __device__ __forceinline__ void build_k_f32(bf16x8 (&kf)[8], const RowF& rowp, int lane) {
    const int r16 = lane & 15, kq = lane >> 4;
#pragma unroll
    for (int f = 0; f < 8; ++f) { const int kt = f >> 1, ks = f & 1; const float* p = rowp(kt * 16 + r16) + ks * 32 + kq * 8; kf[f] = pack8(__builtin_nontemporal_load((const f32x4*)p), __builtin_nontemporal_load((const f32x4*)(p + 4))); }
}
template <class RowF> __device__ __forceinline__ void build_v_f32(bf16x8 (&vf)[8], const RowF& rowp, int lane) {
    const int r16 = lane & 15, kq = lane >> 4;
#pragma unroll
    for (int f = 0; f < 8; ++f) { const int dt = f >> 1, ks2 = f & 1; f32x4 lo, hi;
#pragma unroll
        for (int e = 0; e < 4; ++e) { lo[e] = __builtin_nontemporal_load(rowp(vkey(ks2, kq, e)) + dt * 16 + r16); hi[e] = __builtin_nontemporal_load(rowp(vkey(ks2, kq, e + 4)) + dt * 16 + r16); }
        vf[f] = pack8(lo, hi); }
}
template <class KRowF, class VRowF> __device__ __forceinline__ void build_kv_f32(bf16x8 (&kf)[8], bf16x8 (&vf)[8], const KRowF& krow, const VRowF& vrow, LAS bf16* tile  , int lane) {
    const int r16 = lane & 15, kq = lane >> 4;
    f32x4 vr[16], kr[16];
#pragma unroll
    for (int i = 0; i < 16; ++i) vr[i] = __builtin_nontemporal_load((const f32x4*)(vrow(i * 4 + kq) + r16 * 4));
#pragma unroll
    for (int f = 0; f < 8; ++f) { const int kt = f >> 1, ks = f & 1; const float* p = krow(kt * 16 + r16) + ks * 32 + kq * 8; kr[2 * f] = __builtin_nontemporal_load((const f32x4*)p); kr[2 * f + 1] = __builtin_nontemporal_load((const f32x4*)(p + 4)); }
#pragma unroll
    for (int hv = 0; hv < 2; ++hv) {
#pragma unroll
        for (int i = 0; i < 8; ++i) { const f32x4 x = vr[hv * 8 + i]; v2u o; o.x = pk2(x[0], x[1]); o.y = pk2(x[2], x[3]); *(LAS v2u*)(tile + (i * 4 + kq) * 72 + r16 * 4) = o; }
        LDS_WAIT(); asm volatile("" ::: "memory");
#pragma unroll
        for (int dt = 0; dt < 4; ++dt) { unsigned short v[8];
#pragma unroll
            for (int e = 0; e < 8; ++e) v[e] = tile[((e >> 2) * 16 + kq * 4 + (e & 3)) * 72 + dt * 16 + r16];
            v4u o; o.x = v[0] | ((unsigned)v[1] << 16); o.y = v[2] | ((unsigned)v[3] << 16); o.z = v[4] | ((unsigned)v[5] << 16); o.w = v[6] | ((unsigned)v[7] << 16);
            vf[dt * 2 + hv] = __builtin_bit_cast(bf16x8, o); }
        LDS_WAIT(); asm volatile("" ::: "memory");
    }
#pragma unroll
    for (int f = 0; f < 8; ++f) kf[f] = pack8(kr[2 * f], kr[2 * f + 1]);
}
__device__ __forceinline__ void build_new(bf16x8 (&kf)[8], bf16x8 (&vf)[8], const bf16* PROJ, int rowbase, int kcol, int vcol, int lane) {
    const int r16 = lane & 15, kq = lane >> 4;
#pragma unroll
    for (int f = 0; f < 8; ++f) { const int kt = f >> 1, ks = f & 1;
        kf[f] = (kt == 0 && r16 < 4) ? *(const bf16x8*)(PROJ + (size_t)(rowbase + r16) * NPA + kcol + ks * 32 + kq * 8) : zero8(); }
#pragma unroll
    for (int f = 0; f < 8; ++f) { const int dt = f >> 1, ks2 = f & 1; v4u o = {0u, 0u, 0u, 0u};
        if (ks2 == 0 && kq == 0) { unsigned short v[4];
#pragma unroll
            for (int e = 0; e < 4; ++e) v[e] = PROJ[(size_t)(rowbase + e) * NPA + vcol + dt * 16 + r16];
            o.x = v[0] | ((unsigned)v[1] << 16); o.y = v[2] | ((unsigned)v[3] << 16); }
        vf[f] = __builtin_bit_cast(bf16x8, o); }
}
constexpr int SMP_W = 110592, SMP_PE = SMP_W + 2 * 4096 * 4, SMP_VEC = SMP_PE + 2 * 64 * 4, SMP_KS = SMP_VEC + 8 * 64 * 4, SMP_VS = SMP_KS + 4096;
static_assert(ATT_MERGE + 8 * 2 * 18 * 64 * 4 <= SMP_W && SMP_VS + 4096 <= SCRATCH_BYTES, "sample unit LDS map");
__device__ __forceinline__ void sample_summaries(Frame& F, int a, int s, int g) {
    const int w = F.wave;
    LAS float* Wl = (LAS float*)(F.lds + RING_OFF + SMP_W); LAS float* pem = (LAS float*)(F.lds + RING_OFF + SMP_PE); LAS float* vec = (LAS float*)(F.lds + RING_OFF + SMP_VEC) + w * 64;
    LAS bf16* ks = (LAS bf16*)(F.lds + RING_OFF + SMP_KS); LAS bf16* vs = (LAS bf16*)(F.lds + RING_OFF + SMP_VS);
    const int rg = F.lane >> 4, c4 = F.lane & 15;
    const float* cache = F.cache_nsa();
    const int pagev = F.page_table()[s * NPAGES + (F.lane & 15)];
    f32x4 l0[16], l1[16];
#define SMP_BASE(j_) (cache + ((((size_t)(a * N_POOL + __builtin_amdgcn_readlane(pagev, (j_) >> 1)) * 128 + ((j_) & 1) * 64) * 4 + 0) * 2 + g) * 64 + 4 * c4)
#define SMP_LOAD(dst, p_) do { const float* b_ = (p_); _Pragma("unroll") for (int i = 0; i < 16; ++i) dst[i] = __builtin_nontemporal_load((const f32x4*)(b_ + (size_t)(4 * i + rg) * 512)); } while (0)
    SMP_LOAD(l0, SMP_BASE(w)); SMP_LOAD(l1, SMP_BASE(w) + 128);
    { const float* wc = F.w_cmp() + (size_t)a * 2 * 4096;
      for (int e = F.tid; e < 2 * 4096; e += NWAVES * 64) Wl[e] = wc[e];
      if (F.tid < 128) pem[F.tid] = ((const float*)(F.ws + WS_PEM))[a * 128 + F.tid];
      LDS_WAIT(); __syncthreads(); }
#define SMP_REDUCE(src, kv_, j_) do { f32x4 acc = {0.f, 0.f, 0.f, 0.f}; _Pragma("unroll") for (int i = 0; i < 16; ++i) acc += src[i]; \
        _Pragma("unroll") for (int q = 0; q < 4; ++q) { acc[q] += __shfl_xor(acc[q], 16); acc[q] += __shfl_xor(acc[q], 32); } \
        if (F.lane < 16) { _Pragma("unroll") for (int q = 0; q < 4; ++q) vec[c4 * 4 + q] = acc[q] * (1.0f / 64.0f) + pem[(kv_) * 64 + c4 * 4 + q]; } \
        LDS_WAIT(); asm volatile("" ::: "memory"); } while (0)
#pragma unroll
    for (int r = 0; r < 4; ++r) {
        const int j = w + 8 * r;
        SMP_REDUCE(l0, 0, j);
        if (r < 3) SMP_LOAD(l0, SMP_BASE(j + 8));
        cmp_matvec_store(F, 0, vec, ks, vs, j, 1, SMP_W);
        LDS_WAIT(); asm volatile("" ::: "memory");
        SMP_REDUCE(l1, 1, j);
        if (r < 3) SMP_LOAD(l1, SMP_BASE(j + 8) + 128);
        cmp_matvec_store(F, 1, vec, ks, vs, j, 1, SMP_W);
        LDS_WAIT(); asm volatile("" ::: "memory");
    }
#undef SMP_REDUCE
#undef SMP_LOAD
#undef SMP_BASE
    LDS_WAIT(); __syncthreads();
}
__device__ __forceinline__ void attn_sample_unit(Frame& F, int a, int s, int g) {
    sample_summaries(F, a, s, g); relaunder(F);
#ifdef PROBE_SUM
    __syncthreads(); sample_summaries(F, a, s, g); relaunder(F);
#endif
    const bf16* PROJ = (const bf16*)(F.ws + WS_PROJ);
    const int lane = F.lane, w = F.wave, kq = lane >> 4, c = lane & 15, ql = c >> 2, h = c & 3;
    const LAS float* lut = (const LAS float*)(F.lds + RING_OFF + ATT_LUT) + h * ATT_LUTN;
    LAS float* score = (LAS float*)(F.lds + RING_OFF + ATT_SCORE) + w * 512;
    LAS float* merge = (LAS float*)(F.lds + RING_OFF + ATT_MERGE);
    const int rowbase = MP + s * 4, qpos = PAST + ql, row = rowbase + ql;
    const int pagev = F.page_table()[s * NPAGES + (lane & 15)];
    LAS bf16* vtile = (LAS bf16*)(F.lds + RING_OFF + SMP_W) + w * (32 * 72);
    bf16x8 qf[2];
#pragma unroll
    for (int ks = 0; ks < 2; ++ks) qf[ks] = *(const bf16x8*)(PROJ + (size_t)row * NPA + CQ + (4 * g + h) * 64 + ks * 32 + kq * 8);
    f32x4 oc[4];
    quad_cmp<2, 1>(oc, qf, (const LAS bf16x8*)(F.lds + RING_OFF + SMP_KS), (const LAS bf16x8*)(F.lds + RING_OFF + SMP_VS), 2, qpos, lut, score, lane);
    LDS_WAIT(); asm volatile("" ::: "memory");
    unsigned long long my0 = 0ull, u0 = 0ull;
#pragma unroll
    for (int q = 0; q < 4; ++q) { unsigned long long m0, m1; select_blocks(score + q * 128, 32, lane, m0, m1); u0 |= m0; if (q == ql) my0 = m0; }
    LDS_WAIT(); __syncthreads();
    if (w == 0) { LAS float* op = (LAS float*)(F.lds + RING_OFF + ATT_SCORE) + lane;
#pragma unroll
        for (int dt = 0; dt < 4; ++dt)
#pragma unroll
            for (int i = 0; i < 4; ++i) op[(dt * 4 + i) * 64] = oc[dt][i]; }
    QState st; qs_init(st);
    int item = 0;
#define SMP_PARK(br_) do { LAS float* mp = merge + (size_t)((w * 2 + (br_)) * 18) * 64 + lane; mp[0] = st.m; mp[64] = st.l; \
        _Pragma("unroll") for (int dt = 0; dt < 4; ++dt) { _Pragma("unroll") for (int i = 0; i < 4; ++i) mp[(2 + dt * 4 + i) * 64] = st.o[dt][i]; } } while (0)
    { unsigned long long um = u0 & 0xffffffffull;
      while (um) { const int j = __builtin_ctzll(um); um &= um - 1ull;
        if ((item++ & 7) == w) {
            const int page = __builtin_amdgcn_readlane(pagev, j >> 1);
            const float* kb = F.cache_nsa() + ((((size_t)(a * N_POOL + page) * 128 + (j & 1) * 64) * 4 + 2) * 2 + g) * 64;
            auto kr = [&](int key) { return kb + (size_t)key * 512; }; auto vr = [&](int key) { return kb + 128 + (size_t)key * 512; };
            bf16x8 kf[8], vf[8], pb[2]; build_kv_f32(kf, vf, kr, vr, vtile, lane); quad_qk<0>(st, pb, qf, kf, qpos, j * 64, ((my0 >> j) & 1ull) != 0ull, lut, kq); quad_pv(st, pb, vf);
        } } }
    if ((item++ & 7) == w) { bf16x8 kf[8], vf[8]; build_new(kf, vf, PROJ, rowbase, CKV + 2 * 128 + g * 64, CKV + 3 * 128 + g * 64, lane); bf16x8 pb[2]; quad_qk<0>(st, pb, qf, kf, qpos, PAST, true, lut, kq); quad_pv(st, pb, vf); }
    SMP_PARK(0); qs_init(st);
    for (int jb = 0; jb < 8; ++jb)
        if ((item++ & 7) == w) {
            const float* kb = F.cache_win() + ((((size_t)(a * DEC_B + s) * 512 + jb * 64) * 2 + 0) * 2 + g) * 64;
            auto kr = [&](int key) { return kb + (size_t)key * 256; }; auto vr = [&](int key) { return kb + 128 + (size_t)key * 256; };
            bf16x8 kf[8], vf[8], pb[2]; build_kv_f32(kf, vf, kr, vr, vtile, lane); quad_qk<1>(st, pb, qf, kf, qpos, PAST - 512 + jb * 64, true, lut, kq); quad_pv(st, pb, vf);
        }
    if ((item++ & 7) == w) { bf16x8 kf[8], vf[8]; build_new(kf, vf, PROJ, rowbase, CKV + 4 * 128 + g * 64, CKV + 5 * 128 + g * 64, lane); bf16x8 pb[2]; quad_qk<1>(st, pb, qf, kf, qpos, PAST, true, lut, kq); quad_pv(st, pb, vf); }
    SMP_PARK(1);
#undef SMP_PARK
    LDS_WAIT(); __syncthreads();
    if (w == 0) {
        f32x4 ob[2][4];
#pragma unroll
        for (int br = 0; br < 2; ++br) {
            float mm = -1e30f;
#pragma unroll
            for (int ww = 0; ww < 8; ++ww) mm = fmaxf(mm, merge[(size_t)((ww * 2 + br) * 18) * 64 + lane]);
            float l = 0.f; f32x4 o[4];
#pragma unroll
            for (int dt = 0; dt < 4; ++dt) o[dt] = (f32x4){0.f, 0.f, 0.f, 0.f};
#pragma unroll
            for (int ww = 0; ww < 8; ++ww) { const LAS float* mp = merge + (size_t)((ww * 2 + br) * 18) * 64 + lane; const float sc = fexp2(mp[0] - mm); l += mp[64] * sc;
#pragma unroll
                for (int dt = 0; dt < 4; ++dt)
#pragma unroll
                    for (int i = 0; i < 4; ++i) o[dt][i] += mp[(2 + dt * 4 + i) * 64] * sc; }
            l = xrow16_sum(l); const float inv = l > 0.f ? 1.0f / l : 0.f;
#pragma unroll
            for (int dt = 0; dt < 4; ++dt) ob[br][dt] = o[dt] * inv;
        }
        f32x4 oc2[4]; { const LAS float* op = (const LAS float*)(F.lds + RING_OFF + ATT_SCORE) + lane;
#pragma unroll
            for (int dt = 0; dt < 4; ++dt)
#pragma unroll
                for (int i = 0; i < 4; ++i) oc2[dt][i] = op[(dt * 4 + i) * 64]; }
        int lane2 = lane; asm volatile("" : "+v"(lane2));
        nsa_store(F, a, rowbase + ((lane2 & 15) >> 2), 4 * g + (lane2 & 3), oc2, ob[0], ob[1], lane2 >> 4);
    }
}
constexpr int GM_STAT = 0, GM_VNT = 2048, GM_VSTRIDE = 136;
__device__ __forceinline__ void gmlp_prompt_unit(Frame& F, int a, int chunk, int g) {
    const bf16* PROJ = (const bf16*)(F.ws + WS_PROJ); bf16* YCAT = (bf16*)(F.ws + WS_ACT2);
    const int lane = F.lane, w = F.wave, row0 = chunk * 128, r16 = lane & 15, kq = lane >> 4, nks = (w >> 1) + 1;
    LAS bf16* vnt = (LAS bf16*)(F.lds + RING_OFF + GM_VNT);
    v4u raws[16];
#pragma unroll
    for (int tt = 0; tt < 16; ++tt) raws[tt] = *(const v4u*)(PROJ + (size_t)(row0 + w * 16 + tt) * NPA + CV + lane * 8);
    const bf16* Wsp = (const bf16*)(F.ws + WS_WSP) + (size_t)(a * 4 + g) * 128 * 128;
    bf16x8 bfr[4];
#pragma unroll
    for (int ks = 0; ks < 4; ++ks) bfr[ks] = (ks < nks) ? *(const bf16x8*)(Wsp + (size_t)(w * 16 + r16) * 128 + ks * 32 + kq * 8) : zero8();
    const int tok_e = w * 16 + r16, row_e = row0 + tok_e; v2u uu[8], zz[8];
    const float bs = F.b_sp()[(a * 4 + g) * 128 + tok_e];
    float lg[8], lb[8];
    { const float* pg = F.ln_g() + a * 512 + lane * 8; const float* pb = F.ln_b() + a * 512 + lane * 8;
#pragma unroll
      for (int e = 0; e < 8; ++e) { lg[e] = pg[e]; lb[e] = pb[e]; } }
    float mu[16], rs[16];
#pragma unroll
    for (int tt = 0; tt < 16; ++tt) { const v4u raw = raws[tt]; mu[tt] = ((bflo(raw.x) + bfhi(raw.x)) + (bflo(raw.y) + bfhi(raw.y))) + ((bflo(raw.z) + bfhi(raw.z)) + (bflo(raw.w) + bfhi(raw.w))); }
#pragma unroll
    for (int tt = 0; tt < 16; ++tt) { float x = mu[tt]; x += dpp_q<0xB1>(x); x += dpp_q<0x4E>(x); x += dpp_q<0x124>(x); x += dpp_q<0x128>(x); mu[tt] = x; }
#pragma unroll
    for (int o = 16; o < 64; o <<= 1)
#pragma unroll
        for (int tt = 0; tt < 16; ++tt) mu[tt] += __shfl_xor(mu[tt], o);
#pragma unroll
    for (int tt = 0; tt < 16; ++tt) { mu[tt] *= (1.0f / 512.0f); const v4u raw = raws[tt]; const float m = mu[tt];
        const float d0 = bflo(raw.x) - m, d1 = bfhi(raw.x) - m, d2 = bflo(raw.y) - m, d3 = bfhi(raw.y) - m, d4 = bflo(raw.z) - m, d5 = bfhi(raw.z) - m, d6 = bflo(raw.w) - m, d7 = bfhi(raw.w) - m;
        rs[tt] = ((d0 * d0 + d1 * d1) + (d2 * d2 + d3 * d3)) + ((d4 * d4 + d5 * d5) + (d6 * d6 + d7 * d7)); }
#pragma unroll
    for (int tt = 0; tt < 16; ++tt) { float x = rs[tt]; x += dpp_q<0xB1>(x); x += dpp_q<0x4E>(x); x += dpp_q<0x124>(x); x += dpp_q<0x128>(x); rs[tt] = x; }
#pragma unroll
    for (int o = 16; o < 64; o <<= 1)
#pragma unroll
        for (int tt = 0; tt < 16; ++tt) rs[tt] += __shfl_xor(rs[tt], o);
    if ((lane >> 4) == g) {
#pragma unroll
        for (int tt = 0; tt < 16; ++tt) { const int tok = w * 16 + tt; const v4u raw = raws[tt]; const float m = mu[tt], rstd = rsqrtf(rs[tt] * (1.0f / 512.0f) + EPS);
            const float v[8] = {bflo(raw.x), bfhi(raw.x), bflo(raw.y), bfhi(raw.y), bflo(raw.z), bfhi(raw.z), bflo(raw.w), bfhi(raw.w)};
#pragma unroll
            for (int e = 0; e < 8; ++e) vnt[((lane & 15) * 8 + e) * GM_VSTRIDE + tok] = (bf16)f2bf((v[e] - m) * rstd * lg[e] + lb[e]); }
    }
    LDS_WAIT(); __syncthreads();
#pragma unroll
    for (int dt = 0; dt < 8; ++dt) { const int ch = g * 128 + dt * 16 + kq * 4; uu[dt] = *(const v2u*)(PROJ + (size_t)row_e * NPA + CU + ch); zz[dt] = *(const v2u*)(PROJ + (size_t)row_e * NPA + CZG + ch); }
    f32x4 acc[8];
#pragma unroll
    for (int dt = 0; dt < 8; ++dt) acc[dt] = (f32x4){0.f, 0.f, 0.f, 0.f};
#pragma unroll
    for (int ks = 0; ks < 4; ++ks) {
        if (ks < nks) {
#pragma unroll
            for (int dt = 0; dt < 8; ++dt) { const bf16x8 afr = *(const LAS bf16x8*)(vnt + (dt * 16 + r16) * GM_VSTRIDE + ks * 32 + kq * 8); acc[dt] = mfma16(afr, bfr[ks], acc[dt]); } }
    }
#pragma unroll
    for (int dt = 0; dt < 8; ++dt) { const int ch = g * 128 + dt * 16 + kq * 4; const v2u u = uu[dt], z = zz[dt];
        v2u o; o.x = pk2(bflo(u.x) * (acc[dt][0] + bs) * fsilu(bflo(z.x)), bfhi(u.x) * (acc[dt][1] + bs) * fsilu(bfhi(z.x)));
        o.y = pk2(bflo(u.y) * (acc[dt][2] + bs) * fsilu(bflo(z.y)), bfhi(u.y) * (acc[dt][3] + bs) * fsilu(bfhi(z.y)));
        *(v2u*)(YCAT + (size_t)row_e * D + 512 + ch) = o; }
}
__device__ __forceinline__ void gmlp_sample_unit(Frame& F, int a, int su) {
    const bf16* PROJ = (const bf16*)(F.ws + WS_PROJ); bf16* YCAT = (bf16*)(F.ws + WS_ACT2);
    const int lane = F.lane, w = F.wave, srow = su * 8 + w, row = MP + srow, t = srow & 3;
    LAS float* vn = (LAS float*)(F.lds + RING_OFF);
    const v4u raw = *(const v4u*)(PROJ + (size_t)row * NPA + CV + lane * 8);
    float v[8] = {bflo(raw.x), bfhi(raw.x), bflo(raw.y), bfhi(raw.y), bflo(raw.z), bfhi(raw.z), bflo(raw.w), bfhi(raw.w)};
    float s = 0.f;
#pragma unroll
    for (int e = 0; e < 8; ++e) s += v[e];
    const float mu = wave_sum(s) * (1.0f / 512.0f); float q = 0.f;
#pragma unroll
    for (int e = 0; e < 8; ++e) { const float dlt = v[e] - mu; q += dlt * dlt; }
    const float rstd = rsqrtf(wave_sum(q) * (1.0f / 512.0f) + EPS);
    float* gv = F.out + O_GV + ((size_t)a * MS + srow) * 512 + lane * 8;
#pragma unroll
    for (int e = 0; e < 8; ++e) { const float x = (v[e] - mu) * rstd * F.ln_g()[a * 512 + lane * 8 + e] + F.ln_b()[a * 512 + lane * 8 + e]; v[e] = x; vn[w * 512 + lane * 8 + e] = x; gv[e] = x; }
    LDS_WAIT(); __syncthreads();
    const int g = lane >> 4;
    float mix[8];
#pragma unroll
    for (int e = 0; e < 8; ++e) mix[e] = F.b_sp()[(a * 4 + g) * 128 + t];
    for (int j = 0; j <= t; ++j) { const float wv = F.w_sp()[((size_t)(a * 4 + g) * 128 + t) * 128 + j]; const LAS float* vj = vn + (w - t + j) * 512 + lane * 8;
#pragma unroll
        for (int e = 0; e < 8; ++e) mix[e] += wv * vj[e]; }
    const v4u u = *(const v4u*)(PROJ + (size_t)row * NPA + CU + lane * 8), z = *(const v4u*)(PROJ + (size_t)row * NPA + CZG + lane * 8);
    v4u o;
    o.x = pk2(bflo(u.x) * mix[0] * fsilu(bflo(z.x)), bfhi(u.x) * mix[1] * fsilu(bfhi(z.x)));
    o.y = pk2(bflo(u.y) * mix[2] * fsilu(bflo(z.y)), bfhi(u.y) * mix[3] * fsilu(bfhi(z.y)));
    o.z = pk2(bflo(u.z) * mix[4] * fsilu(bflo(z.z)), bfhi(u.z) * mix[5] * fsilu(bfhi(z.z)));
    o.w = pk2(bflo(u.w) * mix[6] * fsilu(bflo(z.w)), bfhi(u.w) * mix[7] * fsilu(bfhi(z.w)));
    *(v4u*)(YCAT + (size_t)row * D + 512 + lane * 8) = o;
}

#ifndef PROBE_ATT
#define PROBE_ATT 0
#endif
__device__ __forceinline__ void p_attn(Frame& F, int a) {
    constexpr int N_SA = DEC_B * 2, N_PA = BATCH * 2 * 128, N_GP = 128 * 4, N_GS = MS / 8;
    int ns = 0, np = 0;
    for (int r = F.vcu; r < N_SA; r += F.G) ++ns;
    for (int r = F.vcu; r < N_PA; r += F.G) ++np;
    const int pos = (F.vcu >> 3) % 3;
    const int ins = ns == 0 ? -1 : (pos < np ? pos : np);
    int lut_g = -1;
    for (int k = 0; k < np + ns; ++k) {
        int arg; bool smp;
        if (k == ins) { smp = true; arg = F.vcu; }
        else { const int idx = (ns > 0 && k > ins) ? k - 1 : k;
            if (idx >= np) { smp = true; arg = F.vcu + F.G * (idx - np + 1); } else { smp = false; arg = F.vcu + F.G * idx; } }
        __syncthreads(); relaunder(F);
        int g, b = 0, s = 0, qt = 0;
        if (smp) { s = arg >> 1; g = arg & 1; }
        else {
            const int r = arg, kk = r >> 8, x = (r >> 5) & 7, i = r & 31, ci = (x >> 2) * 32 + i;
            b = (x >> 1) & 1; g = x & 1; qt = kk ? ci : 127 - ci; }
        if (g != lut_g) { build_lut(F, g); lut_g = g; }
        LDS_WAIT(); __syncthreads();
        if (smp) attn_sample_unit(F, a, s, g); else attn_prompt_unit(F, a, b, g, qt);
    }
    gu32* qh = F.ctl + CW_GQ + a;
    for (;;) {
        __syncthreads(); relaunder(F);
        if (F.tid == 0) F.MISC[16] = __hip_atomic_fetch_add((unsigned*)qh, 1u, __ATOMIC_RELAXED, __HIP_MEMORY_SCOPE_AGENT);
        LDS_WAIT(); __syncthreads();
        const int idx = __builtin_amdgcn_readfirstlane((int)F.MISC[16]);
        if (idx >= N_GP + N_GS) break;
        if (idx < N_GP) gmlp_prompt_unit(F, a, idx >> 2, idx & 3); else gmlp_sample_unit(F, a, idx - N_GP);
    }
}
constexpr int LR_XC = 0, LR_XF = 17408, LR_AA = LR_XF + 64 * 129 * 4, LR_SEG = LR_AA + 64 * 129 * 4;
template <int MODE>
__device__ __forceinline__ void lru_unit(Frame& F, int c, int chunk  , int hd) {
    const bf16* XBZ = (const bf16*)(F.ws + WS_PROJ); bf16* YL = (bf16*)(F.ws + WS_ACT2);
    const int tid = F.tid, lane = F.lane, w = F.wave;
    LAS bf16* xc = (LAS bf16*)(F.lds + RING_OFF + LR_XC); LAS float* xf = (LAS float*)(F.lds + RING_OFF + LR_XF); LAS float* aa = (LAS float*)(F.lds + RING_OFF + LR_AA); LAS float* seg = (LAS float*)(F.lds + RING_OFF + LR_SEG);
    const int ch = tid & 127, sg = tid >> 7, chg = hd * 128 + ch;
    const int row0 = (MODE == 2) ? MP + chunk * 64 : chunk * 64;
    {
        const float cw0 = F.conv_w()[(c * 4 + 0) * 1024 + chg], cw1 = F.conv_w()[(c * 4 + 1) * 1024 + chg], cw2 = F.conv_w()[(c * 4 + 2) * 1024 + chg], cw3 = F.conv_w()[(c * 4 + 3) * 1024 + chg], cb = F.conv_b()[c * 1024 + chg];
        unsigned short xr[16]; float h3 = 0.f, h2 = 0.f, h1 = 0.f;
#pragma unroll
        for (int r = 0; r < 16; ++r) xr[r] = XBZ[(size_t)(row0 + sg * 16 + r) * 2048 + chg];
        if (MODE != 2) { const int tb = (chunk & 127) * 64 + sg * 16;
            if (tb >= 3) { const bf16* p = XBZ + (size_t)(row0 + sg * 16 - 3) * 2048 + chg; h3 = bf2f(p[0]); h2 = bf2f(p[2048]); h1 = bf2f(p[4096]); } }
        float cs[4][3];
        if (MODE == 2) {
#pragma unroll
            for (int q = 0; q < 4; ++q) { const int s = chunk * 16 + sg * 4 + q; const float* cp = F.state_conv() + ((size_t)(c * DEC_B + s) * 3) * 1024 + chg; cs[q][0] = cp[0]; cs[q][1] = cp[1024]; cs[q][2] = cp[2048]; } }
        float x3 = h3, x2 = h2, x1 = h1;
#pragma unroll
        for (int r = 0; r < 16; ++r) {
            const int rr = sg * 16 + r;
            if (MODE == 2 && (r & 3) == 0) { x3 = cs[r >> 2][0]; x2 = cs[r >> 2][1]; x1 = cs[r >> 2][2]; }
            const float x0 = bf2f(xr[r]);
            const float v = cb + cw0 * x3 + cw1 * x2 + cw2 * x1 + cw3 * x0;
            xf[rr * 129 + ch] = v; xc[rr * 136 + ch] = (bf16)f2bf(v);
            x3 = x2; x2 = x1; x1 = x0;
        }
    }
    LDS_WAIT(); __syncthreads();
    {
        const int r16 = lane & 15, kq = lane >> 4;
        const bf16* WG = (const bf16*)(F.ws + WS_WG) + (size_t)(c * 8 + hd) * 256 * 128;
        f32x4 acc[2][4];
#pragma unroll
        for (int i = 0; i < 2; ++i)
#pragma unroll
            for (int tt = 0; tt < 4; ++tt) acc[i][tt] = (f32x4){0.f, 0.f, 0.f, 0.f};
#pragma unroll
        for (int ks = 0; ks < 4; ++ks) {
            const bf16x8 a0 = *(const bf16x8*)(WG + (size_t)(w * 16 + r16) * 128 + ks * 32 + kq * 8), a1 = *(const bf16x8*)(WG + (size_t)(128 + w * 16 + r16) * 128 + ks * 32 + kq * 8);
#pragma unroll
            for (int tt = 0; tt < 4; ++tt) { const bf16x8 bq = *(const LAS bf16x8*)(xc + (tt * 16 + r16) * 136 + ks * 32 + kq * 8); acc[0][tt] = mfma16(a0, bq, acc[0][tt]); acc[1][tt] = mfma16(a1, bq, acc[1][tt]); }
        }
#pragma unroll
        for (int i = 0; i < 4; ++i) {
            const int cl = w * 16 + kq * 4 + i, cg = hd * 128 + cl;
            const float bra = F.b_rg_a()[c * 1024 + cg], brx = F.b_rg_x()[c * 1024 + cg], lm = F.lam()[c * 1024 + cg];
            const float sp = log1pf(expf(-lm));
#pragma unroll
            for (int tt = 0; tt < 4; ++tt) {
                const int t = tt * 16 + r16;
                const float rg = fsigmoid(acc[0][tt][i] + bra), ig = fsigmoid(acc[1][tt][i] + brx);
                const float av = fexp2(-8.0f * LOG2E * rg * sp), mult = __builtin_amdgcn_sqrtf(fmaxf(1.0f - av * av, 0.f));
                const float xv = xf[t * 129 + cl];
                aa[t * 129 + cl] = av; xf[t * 129 + cl] = mult * ig * xv;
            }
        }
    }
    LDS_WAIT(); __syncthreads();
    if (MODE == 2) {
        float* hout = F.out + O_HS + (size_t)c * DEC_B * 1024;
        unsigned short zr[16]; float h0v[4];
#pragma unroll
        for (int r = 0; r < 16; ++r) zr[r] = XBZ[(size_t)(row0 + sg * 16 + r) * 2048 + 1024 + chg];
#pragma unroll
        for (int q = 0; q < 4; ++q) h0v[q] = F.state_h()[((size_t)c * DEC_B + chunk * 16 + sg * 4 + q) * 1024 + chg];
#pragma unroll
        for (int q = 0; q < 4; ++q) { const int s = chunk * 16 + sg * 4 + q; float hh = h0v[q];
#pragma unroll
            for (int t = 0; t < 4; ++t) { const int rr = sg * 16 + q * 4 + t; hh = aa[rr * 129 + ch] * hh + xf[rr * 129 + ch];
                YL[(size_t)(row0 + rr) * D + chg] = (bf16)f2bf(hh * fsilu(bf2f(zr[q * 4 + t]))); }
            hout[(size_t)s * 1024 + chg] = hh; }
    } else {
        float P = 1.f, H = 0.f;
#pragma unroll 4
        for (int r = 0; r < 16; ++r) { const int rr = sg * 16 + r; const float av = aa[rr * 129 + ch]; H = av * H + xf[rr * 129 + ch]; P *= av; }
        seg[(sg * 128 + ch) * 2] = P; seg[(sg * 128 + ch) * 2 + 1] = H;
        LDS_WAIT(); __syncthreads();
        if (MODE == 0) {
            if (sg == 0) { float Pc = 1.f, Hc = 0.f;
#pragma unroll
                for (int s2 = 0; s2 < 4; ++s2) { const float p = seg[(s2 * 128 + ch) * 2], hq = seg[(s2 * 128 + ch) * 2 + 1]; Hc = p * Hc + hq; Pc *= p; }
                float* ls = (float*)(F.ws + WS_LSUM) + ((size_t)chunk * 1024 + chg) * 2; ls[0] = Pc; ls[1] = Hc; }
        } else {
            float hh = ((const float*)(F.ws + WS_CARRY))[(size_t)chunk * 1024 + chg];
            unsigned short zr[16];
#pragma unroll
            for (int r = 0; r < 16; ++r) zr[r] = XBZ[(size_t)(row0 + sg * 16 + r) * 2048 + 1024 + chg];
            for (int s2 = 0; s2 < sg; ++s2) hh = seg[(s2 * 128 + ch) * 2] * hh + seg[(s2 * 128 + ch) * 2 + 1];
#pragma unroll
            for (int r = 0; r < 16; ++r) { const int rr = sg * 16 + r; hh = aa[rr * 129 + ch] * hh + xf[rr * 129 + ch];
                YL[(size_t)(row0 + rr) * D + chg] = (bf16)f2bf(hh * fsilu(bf2f(zr[r]))); }
        }
    }
}
__device__ __forceinline__ void lru_seg_task(Frame& F, int c, int b, int hd, int sgm) {
    const bf16* XBZ = (const bf16*)(F.ws + WS_PROJ); unsigned* HP = (unsigned*)(F.ws + WS_HP);
    const int tid = F.tid, lane = F.lane, w = F.wave;
    constexpr int XL = 132;
    LAS bf16* xc = (LAS bf16*)(F.lds + RING_OFF); LAS float* xf = (LAS float*)(F.lds + RING_OFF + 17408); LAS float* aa = xf + 64 * XL; LAS float* seg = aa + 64 * XL;
    const int ch = tid & 127, sg = tid >> 7, chg = hd * 128 + ch, r16 = lane & 15, kq = lane >> 4;
    const int cq = tid & 31, rq = tid >> 5, cg4 = hd * 128 + cq * 4;
    f32x4 cw[4], cbv;
#pragma unroll
    for (int k = 0; k < 4; ++k) cw[k] = *(const f32x4*)(F.conv_w() + (c * 4 + k) * 1024 + cg4);
    cbv = *(const f32x4*)(F.conv_b() + c * 1024 + cg4);
    bf16x8 wa[4], wx[4];
    { const bf16* WG = (const bf16*)(F.ws + WS_WG) + (size_t)(c * 8 + hd) * 256 * 128;
#pragma unroll
      for (int ks = 0; ks < 4; ++ks) { wa[ks] = *(const bf16x8*)(WG + (size_t)(w * 16 + r16) * 128 + ks * 32 + kq * 8); wx[ks] = *(const bf16x8*)(WG + (size_t)(128 + w * 16 + r16) * 128 + ks * 32 + kq * 8); } }
    float bra[4], brx[4], sp8[4];
#pragma unroll
    for (int i = 0; i < 4; ++i) { const int cg = hd * 128 + w * 16 + kq * 4 + i; bra[i] = F.b_rg_a()[c * 1024 + cg]; brx[i] = F.b_rg_x()[c * 1024 + cg]; sp8[i] = -8.0f * LOG2E * log1pf(expf(-F.lam()[c * 1024 + cg])); }
    const int rowS = b * T + sgm * 512;
    v2u xr[7];
#define LRU_LOADX(dst, rowc) do { _Pragma("unroll") for (int r = 0; r < 7; ++r) { const int rw = (rowc) + rq * 4 + r - 3; dst[r] = (rw >= b * T) ? *(const v2u*)(XBZ + (size_t)rw * 2048 + cg4) : (v2u){0u, 0u}; } } while (0)
    LRU_LOADX(xr, rowS);
    float Prun = 1.f, Hrun = 0.f;
#pragma nounroll
    for (int kk = 0; kk < 8; ++kk) {
        const int row0 = rowS + kk * 64;
        v2u xn[7];
        if (kk < 7) LRU_LOADX(xn, row0 + 64);
        LDS_BARRIER();
        {
            f32x4 x[7];
#pragma unroll
            for (int r = 0; r < 7; ++r) x[r] = (f32x4){bflo(xr[r].x), bfhi(xr[r].x), bflo(xr[r].y), bfhi(xr[r].y)};
#pragma unroll
            for (int q = 0; q < 4; ++q) { const int rr = rq * 4 + q; const f32x4 v = cbv + cw[0] * x[q] + cw[1] * x[q + 1] + cw[2] * x[q + 2] + cw[3] * x[q + 3];
                *(LAS f32x4*)(xf + rr * XL + cq * 4) = v; v2u o; o.x = pk2(v[0], v[1]); o.y = pk2(v[2], v[3]); *(LAS v2u*)(xc + rr * 136 + cq * 4) = o; }
        }
        LDS_BARRIER();
        {
            f32x4 acc[2][4];
#pragma unroll
            for (int i = 0; i < 2; ++i)
#pragma unroll
                for (int tt = 0; tt < 4; ++tt) acc[i][tt] = (f32x4){0.f, 0.f, 0.f, 0.f};
#pragma unroll
            for (int ks = 0; ks < 4; ++ks)
#pragma unroll
                for (int tt = 0; tt < 4; ++tt) { const bf16x8 bq = *(const LAS bf16x8*)(xc + (tt * 16 + r16) * 136 + ks * 32 + kq * 8); acc[0][tt] = mfma16(wa[ks], bq, acc[0][tt]); acc[1][tt] = mfma16(wx[ks], bq, acc[1][tt]); }
#pragma unroll
            for (int tt = 0; tt < 4; ++tt) { const int t = tt * 16 + r16; LAS f32x4* xp = (LAS f32x4*)(xf + t * XL + w * 16 + kq * 4); LAS f32x4* ap = (LAS f32x4*)(aa + t * XL + w * 16 + kq * 4);
                const f32x4 xv = *xp; f32x4 av4, bv4;
#pragma unroll
                for (int i = 0; i < 4; ++i) { const float rg = fsigmoid(acc[0][tt][i] + bra[i]), ig = fsigmoid(acc[1][tt][i] + brx[i]);
                    const float av = fexp2(rg * sp8[i]), mult = __builtin_amdgcn_sqrtf(fmaxf(1.0f - av * av, 0.f)); av4[i] = av; bv4[i] = mult * ig * xv[i]; }
                *ap = av4; *xp = bv4; }
        }
        LDS_BARRIER();
        float av[16], bv[16]; float P = 1.f, H = 0.f;
#pragma unroll
        for (int r = 0; r < 16; ++r) { av[r] = aa[(sg * 16 + r) * XL + ch]; bv[r] = xf[(sg * 16 + r) * XL + ch]; }
#pragma unroll
        for (int r = 0; r < 16; ++r) { H = av[r] * H + bv[r]; P *= av[r]; }
        seg[(sg * 128 + ch) * 2] = P; seg[(sg * 128 + ch) * 2 + 1] = H;
        LDS_BARRIER();
        float Ps = Prun, Hs = Hrun, Pe = Prun, He = Hrun;
#pragma unroll
        for (int s2 = 0; s2 < 4; ++s2) { const float p = seg[(s2 * 128 + ch) * 2], hq = seg[(s2 * 128 + ch) * 2 + 1]; He = p * He + hq; Pe *= p; if (s2 < sg) { Hs = p * Hs + hq; Ps *= p; } }
        if (kk < 7) {
            asm volatile("s_waitcnt vmcnt(0)" ::: "memory");
#pragma unroll
            for (int r = 0; r < 7; ++r) { xr[r] = xn[r]; asm volatile("" : "+v"(xr[r].x), "+v"(xr[r].y)); } }
        {
            unsigned* hp = HP + (size_t)(row0 + sg * 16) * 1024 + chg; float hh = Hs, pp = Ps;
#pragma unroll
            for (int r = 0; r < 16; ++r) { hh = av[r] * hh + bv[r]; pp *= av[r]; hp[(size_t)r * 1024] = pk2(hh, pp); }
        }
        Prun = Pe; Hrun = He;
    }
#undef LRU_LOADX
    if (sg == 0) { float* ls = (float*)(F.ws + WS_LSUM) + ((size_t)((b * 16 + sgm) * 1024) + chg) * 2; ls[0] = Prun; ls[1] = Hrun; }
}
__device__ __forceinline__ void lru_fix_task(Frame& F, int c, int b, int sgm, int e8) {
    const bf16* XBZ = (const bf16*)(F.ws + WS_PROJ); const unsigned* HP = (const unsigned*)(F.ws + WS_HP); bf16* YL = (bf16*)(F.ws + WS_ACT2);
    const int ch = F.tid * 2;
    float c0 = 0.f, c1 = 0.f;
    { f32x4 sm[15];
#pragma unroll
      for (int s2 = 0; s2 < 15; ++s2) sm[s2] = (s2 < sgm) ? *(const f32x4*)((const float*)(F.ws + WS_LSUM) + ((size_t)((b * 16 + s2) * 1024) + ch) * 2) : (f32x4){1.f, 0.f, 1.f, 0.f};
#pragma unroll
      for (int s2 = 0; s2 < 15; ++s2) { c0 = sm[s2][0] * c0 + sm[s2][1]; c1 = sm[s2][2] * c1 + sm[s2][3]; } }
    const int row0 = b * T + sgm * 512 + e8 * 64;
    float h0 = 0.f, h1 = 0.f;
    v2u hp[2][8]; unsigned zz[2][8]; const unsigned tid = (unsigned)F.tid & 511u;
#define FIX_LOAD(buf, rb_) do { _Pragma("unroll") for (int r = 0; r < 8; ++r) { const size_t row = (size_t)(row0 + (rb_) + r); hp[buf][r] = __builtin_nontemporal_load((const GAS v2u*)(HP + row * 1024) + tid); zz[buf][r] = __builtin_nontemporal_load((const GAS unsigned*)(XBZ + row * 2048 + 1024) + tid); } } while (0)
    FIX_LOAD(0, 0);
#pragma unroll
    for (int bi = 0; bi < 8; ++bi) {
        if (bi < 7) FIX_LOAD((bi + 1) & 1, (bi + 1) * 8);
        asm volatile("" ::: "memory");
#pragma unroll
        for (int r = 0; r < 8; ++r) { const v2u q = hp[bi & 1][r]; const unsigned z = zz[bi & 1][r]; h0 = bflo(q.x) + bfhi(q.x) * c0; h1 = bflo(q.y) + bfhi(q.y) * c1;
            ((GAS unsigned*)(YL + (size_t)(row0 + bi * 8 + r) * D))[tid] = pk2(h0 * fsilu(bflo(z)), h1 * fsilu(bfhi(z))); }
        asm volatile("" ::: "memory");
    }
#undef FIX_LOAD
    if (sgm == 15 && e8 == 7) { float* ho = F.out + O_HP + (size_t)(c * BATCH + b) * 1024 + ch; ho[0] = h0; ho[1] = h1; }
}
__device__ __forceinline__ void p_lru1(Frame& F, int c) {
    constexpr int NPT = BATCH * 8 * 16;
    for (int u = F.vcu; u < NPT; u += F.G) {
        __syncthreads(); relaunder(F);
        lru_seg_task(F, c, u >> 7, u & 7, (u >> 3) & 15);
    }
}
__device__ __forceinline__ void p_lru2(Frame& F, int c) {
    for (int u = F.vcu; u < BATCH * 16 * 8; u += F.G) { relaunder(F); lru_fix_task(F, c, u >> 7, (u >> 3) & 15, u & 7); }
}
template <int NT>
__device__ __forceinline__ void spiece_mma(f32x4 (&acc)[NT], const bf16* X  , const bf16* Wt  , int lane, size_t tstride = (size_t)16 * 1024  ) {
    const int r16 = lane & 15, kq = lane >> 4;
#pragma unroll
    for (int t = 0; t < NT; ++t) acc[t] = (f32x4){0.f, 0.f, 0.f, 0.f};
    const bf16* xp = X + (size_t)r16 * 1024 + kq * 8; const bf16* wp = Wt + (size_t)r16 * 1024 + kq * 8;
#pragma nounroll
    for (int kb = 0; kb < 32; kb += 8) {
        bf16x8 xb[8], wb[NT][8];
#pragma unroll
        for (int k = 0; k < 8; ++k) { xb[k] = *(const bf16x8*)(xp + (kb + k) * 32);
#pragma unroll
            for (int t = 0; t < NT; ++t) wb[t][k] = *(const bf16x8*)(wp + (size_t)t * tstride + (kb + k) * 32); }
#pragma unroll
        for (int k = 0; k < 8; ++k)
#pragma unroll
            for (int t = 0; t < NT; ++t) acc[t] = mfma16(wb[t][k], xb[k], acc[t]);
    }
}
__device__ __forceinline__ void spiece_res(Frame& F, const bf16* Wt) {
    const int lane = F.lane, w = F.wave, r16 = lane & 15, kq = lane >> 4;
    LAS float* red = (LAS float*)(F.lds + RING_OFF);
    for (int p = F.vcu; p < 256; p += F.G) {
        const int rg = p >> 3, cc = p & 7, r0 = MP + rg * 16, c0 = cc * 128 + w * 16;
        f32x4 acc[1]; spiece_mma<1>(acc, (const bf16*)(F.ws + WS_ACT2) + (size_t)r0 * 1024, Wt + (size_t)c0 * 1024, lane);
        const int row = r0 + r16, col = c0 + kq * 4;
        bf16* rp = (bf16*)(F.ws + WS_XG) + (size_t)row * 1024 + col; const v2u q = *(const v2u*)rp;
        const f32x4 v = acc[0] + (f32x4){bflo(q.x), bfhi(q.x), bflo(q.y), bfhi(q.y)};
        v2u xo; xo.x = pk2(v[0], v[1]); xo.y = pk2(v[2], v[3]); *(v2u*)rp = xo;
        float ss = (v[0] * v[0] + v[1] * v[1]) + (v[2] * v[2] + v[3] * v[3]);
        ss += __shfl_xor(ss, 16); ss += __shfl_xor(ss, 32);
        __syncthreads();
        if (kq == 0) red[w * 16 + r16] = ss;
        LDS_WAIT(); __syncthreads();
        if (F.tid < 16) { float s = 0.f;
#pragma unroll
            for (int ww = 0; ww < 8; ++ww) s += red[ww * 16 + F.tid];
            float* sq = (float*)(F.ws + WS_SSQ) + (size_t)(r0 + F.tid) * 16; sq[cc] = s; sq[8 + cc] = 0.f; }
    }
}
__device__ __forceinline__ void spiece_inc(Frame& F, const bf16* Wt, int L) {
    const int lane = F.lane, w = F.wave, r16 = lane & 15, kq = lane >> 4;
    for (int p = F.vcu; p < 256; p += F.G) {
        const int rg = p >> 3, cc = p & 7, r0 = MP + rg * 16, c0 = cc * 256 + w * 32;
        f32x4 acc[2]; spiece_mma<2>(acc, (const bf16*)(F.ws + WS_XG) + (size_t)r0 * 1024, Wt + (size_t)c0 * 1024, lane);
        const int row = r0 + r16; const float ri = pg8::row_rinv((const float*)(F.ws + WS_SSQ), row);
        const int s = (row - MP) >> 2, t = (row - MP) & 3;
#pragma unroll
        for (int tt = 0; tt < 2; ++tt) { const int col = c0 + tt * 16 + kq * 4; const f32x4 v = acc[tt] * ri;
            v2u xo; xo.x = pk2(v[0], v[1]); xo.y = pk2(v[2], v[3]);
            *(v2u*)((bf16*)(F.ws + WS_PROJ) + (size_t)row * 2048 + col) = xo;
            if (col < 1024 && t >= 1) *(f32x4*)(F.out + O_CVS + (((size_t)L * DEC_B + s) * 3 + (t - 1)) * 1024 + col) = v; }
    }
}
__device__ __forceinline__ void spiece_inc_lru(Frame& F, const bf16* Wt, int L) {
    const int lane = F.lane, w = F.wave, r16 = lane & 15, kq = lane >> 4, tid = F.tid;
    LAS float* xs = (LAS float*)(F.lds + RING_OFF);
    LAS float* zs = xs + 16 * 132;
    LAS float* aa = zs + 16 * 132;
    LAS bf16* xc = (LAS bf16*)(aa + 16 * 132);
    for (int p = F.vcu; p < 256; p += F.G) {
        const int rg = p >> 3, hd = p & 7, r0 = MP + rg * 16;
        const int ch = tid & 127, q = tid >> 7, chg = hd * 128 + ch, s = rg * 4 + q;
        const float cw0 = F.conv_w()[(L * 4 + 0) * 1024 + chg], cw1 = F.conv_w()[(L * 4 + 1) * 1024 + chg], cw2 = F.conv_w()[(L * 4 + 2) * 1024 + chg], cw3 = F.conv_w()[(L * 4 + 3) * 1024 + chg], cb = F.conv_b()[L * 1024 + chg];
        const float* cp = F.state_conv() + ((size_t)(L * DEC_B + s) * 3) * 1024 + chg; const float cs0 = cp[0], cs1 = cp[1024], cs2 = cp[2048];
        const float h0 = F.state_h()[((size_t)L * DEC_B + s) * 1024 + chg];
        bf16x8 wa[4], wx[4];
        { const bf16* WG = (const bf16*)(F.ws + WS_WG) + (size_t)(L * 8 + hd) * 256 * 128;
#pragma unroll
          for (int ks = 0; ks < 4; ++ks) { wa[ks] = *(const bf16x8*)(WG + (size_t)(w * 16 + r16) * 128 + ks * 32 + kq * 8); wx[ks] = *(const bf16x8*)(WG + (size_t)(128 + w * 16 + r16) * 128 + ks * 32 + kq * 8); } }
        float bra[4], brx[4], sp8[4];
#pragma unroll
        for (int i = 0; i < 4; ++i) { const int cg = hd * 128 + w * 16 + kq * 4 + i; bra[i] = F.b_rg_a()[L * 1024 + cg]; brx[i] = F.b_rg_x()[L * 1024 + cg]; sp8[i] = -8.0f * LOG2E * log1pf(expf(-F.lam()[L * 1024 + cg])); }
        f32x4 acc[2]; spiece_mma<2>(acc, (const bf16*)(F.ws + WS_XG) + (size_t)r0 * 1024, Wt + (size_t)(hd * 128 + w * 16) * 1024, lane, (size_t)1024 * 1024);
        {
            const int row = r0 + r16; const float ri = pg8::row_rinv((const float*)(F.ws + WS_SSQ), row);
            const f32x4 vx = acc[0] * ri, vz = acc[1] * ri; const int t = r16 & 3, sq = rg * 4 + (r16 >> 2), col = hd * 128 + w * 16 + kq * 4;
            if (t >= 1) *(f32x4*)(F.out + O_CVS + (((size_t)L * DEC_B + sq) * 3 + (t - 1)) * 1024 + col) = vx;
            __syncthreads();
            *(LAS f32x4*)(xs + r16 * 132 + w * 16 + kq * 4) = vx; *(LAS f32x4*)(zs + r16 * 132 + w * 16 + kq * 4) = vz;
        }
        LDS_WAIT(); __syncthreads();
        {
            const float x0 = xs[(q * 4 + 0) * 132 + ch], x1 = xs[(q * 4 + 1) * 132 + ch], x2 = xs[(q * 4 + 2) * 132 + ch], x3 = xs[(q * 4 + 3) * 132 + ch];
            const float v0 = cb + cw0 * cs0 + cw1 * cs1 + cw2 * cs2 + cw3 * x0, v1 = cb + cw0 * cs1 + cw1 * cs2 + cw2 * x0 + cw3 * x1;
            const float v2 = cb + cw0 * cs2 + cw1 * x0 + cw2 * x1 + cw3 * x2, v3 = cb + cw0 * x0 + cw1 * x1 + cw2 * x2 + cw3 * x3;
            xs[(q * 4 + 0) * 132 + ch] = v0; xs[(q * 4 + 1) * 132 + ch] = v1; xs[(q * 4 + 2) * 132 + ch] = v2; xs[(q * 4 + 3) * 132 + ch] = v3;
            xc[(q * 4 + 0) * 136 + ch] = (bf16)f2bf(v0); xc[(q * 4 + 1) * 136 + ch] = (bf16)f2bf(v1); xc[(q * 4 + 2) * 136 + ch] = (bf16)f2bf(v2); xc[(q * 4 + 3) * 136 + ch] = (bf16)f2bf(v3);
        }
        LDS_WAIT(); __syncthreads();
        {
            f32x4 ga = {0.f, 0.f, 0.f, 0.f}, gx = {0.f, 0.f, 0.f, 0.f};
#pragma unroll
            for (int ks = 0; ks < 4; ++ks) { const bf16x8 bq = *(const LAS bf16x8*)(xc + r16 * 136 + ks * 32 + kq * 8); ga = mfma16(wa[ks], bq, ga); gx = mfma16(wx[ks], bq, gx); }
#pragma unroll
            for (int i = 0; i < 4; ++i) { const int cl = w * 16 + kq * 4 + i;
                const float rgv = fsigmoid(ga[i] + bra[i]), ig = fsigmoid(gx[i] + brx[i]);
                const float av = fexp2(rgv * sp8[i]), mult = __builtin_amdgcn_sqrtf(fmaxf(1.0f - av * av, 0.f));
                const float xv = xs[r16 * 132 + cl]; aa[r16 * 132 + cl] = av; xs[r16 * 132 + cl] = mult * ig * xv; }
        }
        LDS_WAIT(); __syncthreads();
        {
            bf16* YL = (bf16*)(F.ws + WS_ACT2); float hh = h0;
#pragma unroll
            for (int t = 0; t < 4; ++t) { const int rr = q * 4 + t; hh = aa[rr * 132 + ch] * hh + xs[rr * 132 + ch];
                YL[(size_t)(r0 + rr) * D + chg] = (bf16)f2bf(hh * fsilu(zs[rr * 132 + ch])); }
            F.out[O_HS + ((size_t)L * DEC_B + s) * 1024 + chg] = hh;
        }
    }
}
#ifndef PROBE_DUP
#define PROBE_DUP 0
#endif
#ifndef MK_MULTI
#define MK_MULTI 0
#endif
constexpr int N_PHASES = 18;
__global__ void __launch_bounds__(NWAVES * 64, 2) hybrid_fwd(Args args) {
    extern __shared__ __attribute__((aligned(16))) unsigned char lds[];
    Frame F;
    F.lds = (LAS unsigned char*)lds;
    F.MISC = (volatile LAS unsigned*)(F.lds + MISC_OFF);
    F.tid = threadIdx.x; F.lane = F.tid & 63; F.wave = __builtin_amdgcn_readfirstlane(F.tid >> 6);
    F.G = gridDim.x; { const int bx = blockIdx.x; F.vcu = (F.G % 8 == 0) ? (bx % 8) * (F.G / 8) + bx / 8 : bx; }
    F.ws = args.ws; F.out = args.out; F.ctl = (gu32*)(args.ws + WS_CTL);
    for (int u = F.tid; u < (LDS_BYTES - LDSCTL_OFF) / 4; u += NWAVES * 64) ((LAS unsigned*)(F.lds + LDSCTL_OFF))[u] = 0u;
    __syncthreads();
    if (F.tid < 29) { const unsigned long long p = (unsigned long long)args.in[F.tid]; LAS unsigned* t = (LAS unsigned*)(F.lds + PTR_OFF) + 2 * F.tid; t[0] = (unsigned)p; t[1] = (unsigned)(p >> 32); }
    __syncthreads();
    XcdBarrier bar; bar.bar = (unsigned*)(F.ctl + CW_BAR); bar.x = 0; bar.st = nullptr; bar.w0 = F.wave == 0;
    if (args.use_bar) bar = xcd_barrier_post((unsigned*)(F.ctl + CW_BAR), F.MISC + 8, F.wave == 0);
    const int lo = args.ph_lo, hi = args.ph_hi; int bid_l = blockIdx.x;
    const int late_rem = ((M / 256) * (NPA / 256)) % (int)gridDim.x; const bool late = late_rem != 0;
#define IN(k) (lo <= (k) && (k) < hi)
#define RELAUNDER() do { int t_ = F.wave * 64 + lane_id(); asm volatile("" : "+v"(t_)); F.tid = t_; F.lane = t_ & 63; \
        unsigned long long w_ = (unsigned long long)args.ws, o_ = (unsigned long long)args.out; asm volatile("" : "+s"(w_), "+s"(o_)); F.ws = (unsigned char*)(GAS unsigned char*)w_; F.out = (float*)(GAS float*)o_; F.ctl = (gu32*)(F.ws + WS_CTL); int b_ = blockIdx.x, g_ = gridDim.x; asm volatile("" : "+s"(b_), "+s"(g_)); bid_l = b_; F.G = g_; } while (0)
#define SEAM(k) do { if (IN(k) && IN((k) + 1)) { xcd_barrier(bar); if (PROBE_DUP & 128) xcd_barrier(bar); } } while (0)
#define WSP(T, off) ((T*)(F.ws + (off)))

    static_assert(pg8::PW_KSLC == WS_KSLC && pg8::PW_VSLC == WS_VSLC && pg8::PW_KWIN == WS_KWIN && pg8::PW_VWIN == WS_VWIN && pg8::PW_MEAN == WS_MEAN && RING_BYTES + pg8::RINV_OFF + 1024 <= SCRATCH_BYTES, "epilogue map");
    static_assert(pg8::PO_NSAP == O_NSAP && pg8::PO_NSAS == O_NSAS && pg8::PO_WINP == O_WINP && pg8::PO_WINS == O_WINS && pg8::PO_CVP == O_CVP && pg8::PO_CVS == O_CVS, "output map");
    if (IN(0)) {
#ifndef NO_P0
 for (int rep = 0; rep < ((PROBE_DUP & 64) ? 2 : 1); ++rep) { if (rep) xcd_barrier(bar); RELAUNDER(); p0_prologue(F, !late); }
#endif
 } SEAM(0);
    for (int L = 0; L < 2; ++L) {
        const int pb = 1 + 8 * L;
        if (IN(pb + 0)) {
            RELAUNDER();
            pg8::Gemm g{WSP(bf16, WS_XG), (const bf16*)(F.ws + WS_WINA) + (size_t)L * NPA * D, M, NPA, D}; pg8::StaticOrder S; S.init(M, NPA, F.G, bid_l);
            pg8::EpiInA E{WSP(bf16, WS_PROJ), WSP(float, WS_SSQ), F.out, L, F.ws, F.lds + RING_OFF + RING_BYTES};
#ifndef NO_GEMM
            for (int rep = 0; rep < ((PROBE_DUP & 4) ? 2 : 1); ++rep) { if (rep) xcd_barrier(bar); pg8::gemm_phase<pg8::EpiInA, pg8::StaticOrder, true, true>(F.lds + RING_OFF, g, S, E, F.wave); }
#endif
            if (L == 0 && late && bid_l >= late_rem) { __syncthreads(); RELAUNDER(); p0_late(F, bid_l - late_rem, F.G - late_rem); }
        } SEAM(pb + 0);
        if (IN(pb + 1)) {
#ifndef NO_PREP
 for (int rep = 0; rep < ((PROBE_DUP & 8) ? 2 : 1); ++rep) { if (rep) xcd_barrier(bar); RELAUNDER(); p_prep(F, L); }
#endif
 } SEAM(pb + 1);
        if (IN(pb + 2)) {
#ifndef NO_ATTN
 for (int rep = 0; rep < ((PROBE_DUP & 1) ? 2 : 1); ++rep) { if (rep) xcd_barrier(bar); RELAUNDER(); p_attn(F, L); }
#endif
 } SEAM(pb + 2);
        if (IN(pb + 3)) {
            RELAUNDER();
            pg8::Gemm g{WSP(bf16, WS_ACT2), (const bf16*)(F.ws + WS_WOUTA) + (size_t)L * D * D, MP, D, D}; pg8::StaticOrder S; S.init(MP, D, F.G, bid_l);
            pg8::EpiRes E{WSP(bf16, WS_XG), WSP(float, WS_SSQ)};
#ifndef NO_GEMM
            pg8::gemm_phase<pg8::EpiRes, pg8::StaticOrder, true, true>(F.lds + RING_OFF, g, S, E, F.wave);
            RELAUNDER(); spiece_res(F, (const bf16*)(F.ws + WS_WOUTA) + (size_t)L * D * D);
#endif
        } SEAM(pb + 3);
        if (IN(pb + 4)) {
            RELAUNDER();
            pg8::Gemm g{WSP(bf16, WS_XG), (const bf16*)(F.ws + WS_WINC) + (size_t)L * 2048 * D, MP, 2048, D}; pg8::StaticOrder S; S.init(MP, 2048, F.G, bid_l);
            pg8::EpiInC E{WSP(bf16, WS_PROJ), WSP(float, WS_SSQ), F.out, L, F.lds + RING_OFF + RING_BYTES};
#ifndef NO_GEMM
            for (int rep = 0; rep < ((PROBE_DUP & 16) ? 2 : 1); ++rep) { if (rep) xcd_barrier(bar); pg8::gemm_phase<pg8::EpiInC, pg8::StaticOrder, true, true>(F.lds + RING_OFF, g, S, E, F.wave); }
            RELAUNDER(); spiece_inc_lru(F, (const bf16*)(F.ws + WS_WINC) + (size_t)L * 2048 * D, L);
#endif
        } SEAM(pb + 4);
        if (IN(pb + 5)) { for (int rep = 0; rep < ((PROBE_DUP & 32) ? 2 : 1); ++rep) { if (rep) xcd_barrier(bar); RELAUNDER(); p_lru1(F, L); } } SEAM(pb + 5);
        if (IN(pb + 6)) { for (int rep = 0; rep < ((PROBE_DUP & 2) ? 2 : 1); ++rep) { if (rep) xcd_barrier(bar); RELAUNDER(); p_lru2(F, L); } } SEAM(pb + 6);
        if (IN(pb + 7)) {
            RELAUNDER();
            pg8::Gemm g{WSP(bf16, WS_ACT2), (const bf16*)(F.ws + WS_WOUTC) + (size_t)L * D * D, MP, D, D}; pg8::StaticOrder S; S.init(MP, D, F.G, bid_l);
            pg8::EpiRes E{WSP(bf16, WS_XG), WSP(float, WS_SSQ)};
#ifndef NO_GEMM
            pg8::gemm_phase<pg8::EpiRes, pg8::StaticOrder, true, true>(F.lds + RING_OFF, g, S, E, F.wave);
            RELAUNDER(); spiece_res(F, (const bf16*)(F.ws + WS_WOUTC) + (size_t)L * D * D);
#endif
        } SEAM(pb + 7);
    }
    if (IN(17)) {
#ifndef NO_FINAL
 RELAUNDER(); p_final(F);
#endif
 }
#undef IN
#undef SEAM
}

extern "C" void kernel_launch(void* const* d_in, const int* in_sizes, int n_in, void* d_out, int out_size, void* d_ws, size_t ws_size, hipStream_t stream) {
    static int grid = 0;
    if (grid == 0) {
        if (n_in != 29 || (size_t)out_size != O_END || ws_size < WS_END) { fprintf(stderr, "kernel_launch: unexpected shapes: n_in %d out %d ws %zu\n", n_in, out_size, ws_size); grid = -1; return; }
        int dev = 0, cus = 0, per_cu = 0;
        if (hipGetDevice(&dev) != hipSuccess || hipDeviceGetAttribute(&cus, hipDeviceAttributeMultiprocessorCount, dev) != hipSuccess) { grid = -1; return; }
        if (hipFuncSetAttribute((const void*)hybrid_fwd, hipFuncAttributeMaxDynamicSharedMemorySize, LDS_BYTES) != hipSuccess) { fprintf(stderr, "kernel_launch: hipFuncSetAttribute failed\n"); grid = -1; return; }
        if (hipOccupancyMaxActiveBlocksPerMultiprocessor(&per_cu, (const void*)hybrid_fwd, NWAVES * 64, LDS_BYTES) != hipSuccess || per_cu < 1)
            fprintf(stderr, "kernel_launch: note: occupancy query reports %d workgroups per CU\n", per_cu);
        (void)hipGetLastError();
        grid = cus;
    }
    if (grid < 0) return;
    if (hipMemsetAsync((char*)d_ws + WS_CTL, 0, CTL_ZERO_BYTES, stream) != hipSuccess) return;
    Args a{};
    for (int i = 0; i < 29; ++i) a.in[i] = d_in[i];
    a.out = (float*)d_out; a.ws = (unsigned char*)d_ws; a.pad = 0;
#if MK_MULTI
    for (int p = 0; p < N_PHASES; ++p) { a.ph_lo = p; a.ph_hi = p + 1; a.use_bar = 0; hipLaunchKernelGGL(hybrid_fwd, dim3(grid), dim3(NWAVES * 64), LDS_BYTES, stream, a); }
#else
    a.ph_lo = 0; a.ph_hi = N_PHASES; a.use_bar = 1;
    hipLaunchKernelGGL(hybrid_fwd, dim3(grid), dim3(NWAVES * 64), LDS_BYTES, stream, a);
#endif
}
```
